# Optimizing an MI355X kernel written in HIP

```python
import math
import jax, jax.numpy as jnp
from jax import lax
import numpy as np

D_MODEL = 1024
BATCH = 8
SEQ = 4096
DEPTH = 2

N_MIXERS = 2
N_META = 16
POOL_WINDOWS = (2, 4, 8, 16)
N_POOL_GROUPS = len(POOL_WINDOWS)
POOL_GC = D_MODEL // N_POOL_GROUPS
HEAD_DIM = 64
N_HEADS = D_MODEL // (2 * HEAD_DIM)
V_DIM = 2 * HEAD_DIM
Q_BLOCK = 128
N_BUCKETS = 32
MAX_DISTANCE = 128
D_FF = ((8 * D_MODEL + 3 * 256 - 1) // (3 * 256)) * 256
N_POOL_LAYERS = (DEPTH + 1) // 2
N_ATTN_LAYERS = DEPTH // 2
RMS_EPS = 1e-6
NEG_INF = -1e30

kernel_name = "hybrid_pool_diffattn_swiglu"


def rms_norm(x, g):
    xf = x.astype(jnp.float32)
    y = xf * lax.rsqrt(jnp.mean(xf * xf, axis=-1, keepdims=True) + RMS_EPS)
    return (y * g.astype(jnp.float32)).astype(x.dtype)


def pool_mixer(h, w_groups, scale):
    B, L, D = h.shape
    hf = h.astype(jnp.float32)
    c0 = jnp.concatenate([jnp.zeros((B, 1, D), jnp.float32), jnp.cumsum(hf, axis=1)], axis=1)
    t = jnp.arange(L)
    outs = []
    for g, w in enumerate(POOL_WINDOWS):
        sl = slice(g * POOL_GC, (g + 1) * POOL_GC)
        cg = c0[:, :, sl]
        lead = jnp.concatenate([jnp.zeros((B, w - 1, POOL_GC), jnp.float32), cg[:, : L + 1 - w]], axis=1)
        cnt = jnp.minimum(t + 1, w).astype(jnp.float32)[None, :, None]
        pooled = (cg[:, 1:] - lead) / cnt - hf[:, :, sl]
        outs.append(pooled.astype(h.dtype) @ w_groups[g])
    return jnp.concatenate(outs, axis=-1) * scale


def t5_causal_bucket(rel):
    n = jnp.maximum(rel, 0)
    max_exact = N_BUCKETS // 2
    nf = jnp.maximum(n, max_exact).astype(jnp.float32)
    large = max_exact + (jnp.log(nf / max_exact) / math.log(MAX_DISTANCE / max_exact)
                         * (N_BUCKETS - max_exact)).astype(jnp.int32)
    large = jnp.minimum(large, N_BUCKETS - 1)
    return jnp.where(n < max_exact, n, large)


def diff_attention(h, w_qkv, w_o, lq1, lk1, lq2, lk2, subln_g, rel_bias, lambda_init):
    B, L, D = h.shape
    Lp = ((L + Q_BLOCK - 1) // Q_BLOCK) * Q_BLOCK
    pad = ((0, 0), (0, Lp - L), (0, 0))
    qkv = h @ w_qkv
    q, k, v = jnp.split(qkv, 3, axis=-1)
    q = jnp.pad(q, pad).reshape(B, Lp, N_HEADS, 2, HEAD_DIM).transpose(0, 2, 3, 1, 4)
    k = jnp.pad(k, pad).reshape(B, Lp, N_HEADS, 2, HEAD_DIM).transpose(0, 2, 3, 1, 4)
    v = jnp.pad(v, pad).reshape(B, Lp, N_HEADS, V_DIM).transpose(0, 2, 1, 3).astype(jnp.float32)
    lam = (jnp.exp(jnp.sum(lq1.astype(jnp.float32) * lk1.astype(jnp.float32)))
           - jnp.exp(jnp.sum(lq2.astype(jnp.float32) * lk2.astype(jnp.float32))) + lambda_init)
    scale = 1.0 / math.sqrt(HEAD_DIM)
    kpos = jnp.arange(Lp)

    def block(i):
        q0 = i * Q_BLOCK
        qb = lax.dynamic_slice_in_dim(q, q0, Q_BLOCK, axis=3)
        rel = (q0 + jnp.arange(Q_BLOCK))[:, None] - kpos[None, :]
        bias = rel_bias[t5_causal_bucket(rel)].astype(jnp.float32).transpose(2, 0, 1)
        s = jnp.einsum('bhmqd,bhmkd->bhmqk', qb, k).astype(jnp.float32) * scale + bias[None, :, None]
        s = jnp.where(rel >= 0, s, NEG_INF)
        p = jax.nn.softmax(s, axis=-1)
        a = p[:, :, 0] - lam * p[:, :, 1]
        return jnp.einsum('bhqk,bhkv->bhqv', a, v)

    o = lax.map(block, jnp.arange(Lp // Q_BLOCK))
    o = o.transpose(1, 0, 3, 2, 4).reshape(B, Lp, N_HEADS, V_DIM)[:, :L]
    o = rms_norm(o, subln_g) * (1.0 - lambda_init)
    return o.reshape(B, L, D).astype(h.dtype) @ w_o


def swiglu(h, w_gate, w_up, w_down):
    return (jax.nn.silu(h @ w_gate) * (h @ w_up)) @ w_down


def setup_inputs(seed: int = 0) -> dict:
    key = jax.random.key(seed)
    ks = jax.random.split(key, 20)
    f32 = jnp.float32
    nrm = lambda k, s, sc: jax.random.normal(k, s, f32) * sc
    D, F = D_MODEL, D_FF
    return {
        "x": nrm(ks[0], (BATCH, SEQ, D), 1.0),
        "meta_tokens": nrm(ks[1], (N_META, D), 1.0),
        "rel_bias": nrm(ks[2], (N_BUCKETS, N_HEADS), 0.5),
        "mix_norm_g": 1.0 + nrm(ks[3], (DEPTH, D), 0.05),
        "ffn_norm_g": 1.0 + nrm(ks[4], (DEPTH, D), 0.05),
        "pool_w": nrm(ks[5], (N_POOL_LAYERS, N_POOL_GROUPS, POOL_GC, POOL_GC), POOL_GC ** -0.5),
        "pool_scale": 1.0 + nrm(ks[6], (N_POOL_LAYERS, D), 0.1),
        "attn_w_qkv": nrm(ks[7], (N_ATTN_LAYERS, D, 3 * D), D ** -0.5),
        "attn_w_o": nrm(ks[8], (N_ATTN_LAYERS, D, D), D ** -0.5),
        "lambda_q1": nrm(ks[9], (N_ATTN_LAYERS, HEAD_DIM), 0.1),
        "lambda_k1": nrm(ks[10], (N_ATTN_LAYERS, HEAD_DIM), 0.1),
        "lambda_q2": nrm(ks[11], (N_ATTN_LAYERS, HEAD_DIM), 0.1),
        "lambda_k2": nrm(ks[12], (N_ATTN_LAYERS, HEAD_DIM), 0.1),
        "subln_g": 1.0 + nrm(ks[13], (N_ATTN_LAYERS, V_DIM), 0.05),
        "ffn_w_gate": nrm(ks[14], (DEPTH, D, F), D ** -0.5),
        "ffn_w_up": nrm(ks[15], (DEPTH, D, F), D ** -0.5),
        "ffn_w_down": nrm(ks[16], (DEPTH, F, D), F ** -0.5),
        "final_norm_g": 1.0 + nrm(ks[17], (D,), 0.05),
    }


def reference(x, meta_tokens, rel_bias, mix_norm_g, ffn_norm_g, pool_w, pool_scale,
              attn_w_qkv, attn_w_o, lambda_q1, lambda_k1, lambda_q2, lambda_k2, subln_g,
              ffn_w_gate, ffn_w_up, ffn_w_down, final_norm_g):
    B = x.shape[0]
    meta = jnp.broadcast_to(meta_tokens.astype(x.dtype)[None], (B, N_META, D_MODEL))
    h = jnp.concatenate([meta, x], axis=1)
    for i in range(DEPTH):
        hn = rms_norm(h, mix_norm_g[i])
        j = i // N_MIXERS
        if i % N_MIXERS == 0:
            h = h + pool_mixer(hn, pool_w[j], pool_scale[j])
        else:
            lambda_init = 0.8 - 0.6 * math.exp(-0.3 * i)
            h = h + diff_attention(hn, attn_w_qkv[j], attn_w_o[j], lambda_q1[j], lambda_k1[j],
                                   lambda_q2[j], lambda_k2[j], subln_g[j], rel_bias, lambda_init)
        h = h + swiglu(rms_norm(h, ffn_norm_g[i]), ffn_w_gate[i], ffn_w_up[i], ffn_w_down[i])
    h = rms_norm(h, final_norm_g)
    return h[:, N_META:]
```

```cpp
#include <hip/hip_runtime.h>
#include <cstdio>
#include <cstdint>

#define LAS __attribute__((address_space(3)))
#define GAS __attribute__((address_space(1)))

typedef unsigned short bf16_t;
typedef short bf16x8 __attribute__((ext_vector_type(8)));
typedef short s16x4 __attribute__((ext_vector_type(4)));
typedef float f32x4 __attribute__((ext_vector_type(4)));
typedef float f32x2 __attribute__((ext_vector_type(2)));
typedef float f32x16 __attribute__((ext_vector_type(16)));
typedef unsigned u32x4 __attribute__((ext_vector_type(4)));
typedef unsigned u32x2 __attribute__((ext_vector_type(2)));
typedef __bf16 bf16x2_t __attribute__((ext_vector_type(2)));

constexpr int D = 1024, NB = 8, SEQ = 4096, NMETA = 16, FF = 2816, NH = 8;
constexpr int MMAIN = NB * SEQ;
constexpr int META0 = MMAIN;
constexpr int MPAD = MMAIN + 256;
constexpr float RMS_EPS = 1e-6f;
constexpr float LOG2E = 1.4426950408889634f;
constexpr float QSCALE = 0.125f * LOG2E;
constexpr float LAMBDA_INIT = 0.35550906759096926f;

__device__ __forceinline__ unsigned cvtpk(float lo, float hi) { f32x2 v = {lo, hi}; bf16x2_t b = __builtin_convertvector(v, bf16x2_t); return __builtin_bit_cast(unsigned, b); }
__device__ __forceinline__ float wave_sum(float v) {
#pragma unroll
    for (int o = 1; o < 64; o <<= 1) v += __shfl_xor(v, o);
    return v;
}

namespace pg8 {
constexpr int SSQ_LDS = 131072 + 8192;
constexpr int BM = 256, BK = 64, HALF = 128, HTB = HALF * BK * 2, STAGE_BYTES = 8 * HTB, NXCD = 8, WGM = 4;
__host__ __device__ __forceinline__ int lds_byte(int r, int c) { const int st = (r >> 4) * 2 + (c >> 5), rr = r & 15, cc = c & 31, ob = rr * 64 + cc * 2; return st * 1024 + (ob ^ (((ob >> 9) & 1) << 5)); }
__host__ __device__ __forceinline__ void stage_rc(int b, int& R, int& C) { const int st = b / 1024, sb = b % 1024, swz = sb ^ (((sb >> 9) & 1) << 5); R = (st >> 1) * 16 + swz / 64; C = (st & 1) * 32 + (swz % 64) / 2; }
__host__ __device__ __forceinline__ int perm32(int rho) { const int n = rho >> 4, i = rho & 15; return 8 * (i >> 2) + 4 * n + (i & 3); }

struct Unit { int pm, pn; };
struct Gemm { const bf16_t* A; const bf16_t* Bt; int M, N, K; int lda; int a_pn_off; int m_full; };

struct StaticOrder {
    int nM, nN, nwg, G, c;
    __device__ void init(int M, int N, int G_, int c_) { nM = M / BM; nN = N / BM; nwg = nM * nN; G = G_; c = c_; }
    __device__ bool next(int i, Unit& u) const {
        const long L = (long)i * G + c; if (L >= nwg) return false;
        int wgid = (int)L; { const int q = nwg / NXCD, r = nwg % NXCD, xcd = wgid % NXCD, off = wgid / NXCD; wgid = (xcd < r ? xcd * (q + 1) : r * (q + 1) + (xcd - r) * q) + off; }
        const int nig = WGM * nN, gid = wgid / nig, fm = gid * WGM, gsz = (nM - fm) < WGM ? (nM - fm) : WGM;
        u.pm = fm + ((wgid % nig) % gsz); u.pn = (wgid % nig) / gsz; return true;
    }
};

struct MetaOrder {
    int pm, nN, c;
    __device__ bool next(int i, Unit& u) const { if (i > 0 || c >= nN) return false; u.pm = pm; u.pn = c; return true; }
};

__device__ __forceinline__ float row_rstd(const float* ssq, int row) {
    const f32x4* p = (const f32x4*)(ssq + (size_t)row * 16);
    const f32x4 a = p[0], b = p[1], c = p[2], d = p[3];
    const float s = ((a[0] + a[1]) + (a[2] + a[3])) + ((b[0] + b[1]) + (b[2] + b[3])) + ((c[0] + c[1]) + (c[2] + c[3])) + ((d[0] + d[1]) + (d[2] + d[3]));
    return __builtin_amdgcn_rsqf(s * (1.0f / D) + RMS_EPS);
}

__device__ __forceinline__ float row_rstd_lds(LAS const unsigned char* blk, int r) {
    const LAS f32x4* p = (const LAS f32x4*)(blk + r * 64);
    const f32x4 a = p[0], b = p[1], c = p[2], d = p[3];
    const float s = ((a[0] + a[1]) + (a[2] + a[3])) + ((b[0] + b[1]) + (b[2] + b[3])) + ((c[0] + c[1]) + (c[2] + c[3])) + ((d[0] + d[1]) + (d[2] + d[3]));
    return __builtin_amdgcn_rsqf(s * (1.0f / D) + RMS_EPS);
}

struct EpiRes {
    static constexpr bool PERM = true; static constexpr bool RSTD_LDS = false; static constexpr int NSTORES = 16;
    const float* r_main; int n_main; const float* r_aux; int n_aux;
    const bf16_t* r_bf;
    bf16_t* Hb; float* ssq;
    __device__ __forceinline__ void finish(const f32x4 (&acc)[2][2][4][2], int ai, int m, int bj, int row, int col, const f32x4& r0, const f32x4& r1, float& s) const {
        const f32x4 v0 = acc[ai][bj][m][0] + r0, v1 = acc[ai][bj][m][1] + r1;
        u32x4 w; w[0] = cvtpk(v0[0], v0[1]); w[1] = cvtpk(v0[2], v0[3]); w[2] = cvtpk(v1[0], v1[1]); w[3] = cvtpk(v1[2], v1[3]);
        *(u32x4*)(Hb + (size_t)row * D + col) = w;
        s += (v0[0] * v0[0] + v0[1] * v0[1]) + (v0[2] * v0[2] + v0[3] * v0[3]) + (v1[0] * v1[0] + v1[1] * v1[1]) + (v1[2] * v1[2] + v1[3] * v1[3]);
    }
    __device__ __forceinline__ void operator()(const f32x4 (&acc)[2][2][4][2], const Unit& u, int wr, int wc, int fr, int fq) const {
        const int col0 = u.pn * BM + wc * 32 + 8 * fq;
        const int row0 = u.pm * BM + wr * 64 + fr;
        if (r_bf) {
            u32x4 rb[2][4][2];
#pragma unroll
            for (int ai = 0; ai < 2; ++ai)
#pragma unroll
                for (int m = 0; m < 4; ++m)
#pragma unroll
                    for (int bj = 0; bj < 2; ++bj) rb[ai][m][bj] = *(const u32x4*)(r_bf + (size_t)(row0 + ai * HALF + m * 16) * D + col0 + bj * HALF);
#pragma unroll
            for (int ai = 0; ai < 2; ++ai)
#pragma unroll
                for (int m = 0; m < 4; ++m) {
                    const int row = row0 + ai * HALF + m * 16;
                    float s = 0.f;
#pragma unroll
                    for (int bj = 0; bj < 2; ++bj) { const u32x4 q = rb[ai][m][bj];
                        const f32x4 r0 = {__uint_as_float(q[0] << 16), __uint_as_float(q[0] & 0xffff0000u), __uint_as_float(q[1] << 16), __uint_as_float(q[1] & 0xffff0000u)};
                        const f32x4 r1 = {__uint_as_float(q[2] << 16), __uint_as_float(q[2] & 0xffff0000u), __uint_as_float(q[3] << 16), __uint_as_float(q[3] & 0xffff0000u)};
                        finish(acc, ai, m, bj, row, col0 + bj * HALF, r0, r1, s); }
                    s += __shfl_xor(s, 16); s += __shfl_xor(s, 32);
                    if (fq == 0) ssq[(size_t)row * 16 + u.pn * 4 + wc] = s;
                }
        } else {
#pragma unroll
            for (int ai = 0; ai < 2; ++ai) {
                f32x4 rf[4][2][2];
#pragma unroll
                for (int m = 0; m < 4; ++m) {
                    const int row = row0 + ai * HALF + m * 16;
                    const float* rp = row < n_main ? r_main + (size_t)row * D : ((row - n_main) < n_aux ? r_aux + (size_t)(row - n_main) * D : nullptr);
#pragma unroll
                    for (int bj = 0; bj < 2; ++bj) { rf[m][bj][0] = (f32x4){0.f, 0.f, 0.f, 0.f}; rf[m][bj][1] = (f32x4){0.f, 0.f, 0.f, 0.f};
                        if (rp) { rf[m][bj][0] = *(const f32x4*)(rp + col0 + bj * HALF); rf[m][bj][1] = *(const f32x4*)(rp + col0 + bj * HALF + 4); } }
                }
#pragma unroll
                for (int m = 0; m < 4; ++m) {
                    const int row = row0 + ai * HALF + m * 16;
                    float s = 0.f;
#pragma unroll
                    for (int bj = 0; bj < 2; ++bj) finish(acc, ai, m, bj, row, col0 + bj * HALF, rf[m][bj][0], rf[m][bj][1], s);
                    s += __shfl_xor(s, 16); s += __shfl_xor(s, 32);
                    if (fq == 0) ssq[(size_t)row * 16 + u.pn * 4 + wc] = s;
                }
            }
        }
    }
};

struct EpiSwiGLU {
    static constexpr bool PERM = true; static constexpr bool RSTD_LDS = true; static constexpr int NSTORES = 8;
    bf16_t* ACT; const float* ssq; LAS const unsigned char* blk;
    __device__ __forceinline__ void operator()(const f32x4 (&acc)[2][2][4][2], const Unit& u, int wr, int wc, int fr, int fq) const {
        const int col0 = u.pn * HALF + wc * 32 + 8 * fq;
        const int ln = fq * 16 + fr;
        const float rsA = row_rstd_lds(blk, wr * 64 + ln), rsB = row_rstd_lds(blk, HALF + wr * 64 + ln);
#pragma unroll
        for (int ai = 0; ai < 2; ++ai)
#pragma unroll
            for (int m = 0; m < 4; ++m) {
                const int row = u.pm * BM + ai * HALF + wr * 64 + m * 16 + fr;
                const float rs = __shfl(ai ? rsB : rsA, m * 16 + fr);
                float o[8];
#pragma unroll
                for (int n = 0; n < 2; ++n)
#pragma unroll
                    for (int e = 0; e < 4; ++e) {
                        const float g = acc[ai][0][m][n][e] * rs, up = acc[ai][1][m][n][e] * rs;
                        const float sg = __builtin_amdgcn_rcpf(1.0f + __builtin_amdgcn_exp2f(-g * LOG2E));
                        o[n * 4 + e] = g * sg * up;
                    }
                u32x4 w; w.x = cvtpk(o[0], o[1]); w.y = cvtpk(o[2], o[3]); w.z = cvtpk(o[4], o[5]); w.w = cvtpk(o[6], o[7]);
                *(u32x4*)(ACT + (size_t)row * FF + col0) = w;
            }
    }
};

struct EpiQKV {
    static constexpr bool PERM = true; static constexpr bool RSTD_LDS = true; static constexpr int NSTORES = 16;
    bf16_t* Q; size_t tstride; const float* ssq; unsigned* kmax; LAS const unsigned char* blk;
    __device__ __forceinline__ void operator()(const f32x4 (&acc)[2][2][4][2], const Unit& u, int wr, int wc, int fr, int fq) const {
        float kx0 = 0.f, kx1 = 0.f;
        const int t = u.pn >> 2; bf16_t* base = Q + (size_t)t * tstride; const float sc = (t == 0) ? QSCALE : 1.0f;
        const int col0 = (u.pn & 3) * BM + wc * 32 + 8 * fq;
        const int ln = fq * 16 + fr;
        const float rsA = row_rstd_lds(blk, wr * 64 + ln), rsB = row_rstd_lds(blk, HALF + wr * 64 + ln);
#pragma unroll
        for (int ai = 0; ai < 2; ++ai)
#pragma unroll
            for (int m = 0; m < 4; ++m) {
                const int row = u.pm * BM + ai * HALF + wr * 64 + m * 16 + fr;
                const float rs = __shfl(ai ? rsB : rsA, m * 16 + fr) * sc;
#pragma unroll
                for (int bj = 0; bj < 2; ++bj) {
                    const f32x4 v0 = acc[ai][bj][m][0] * rs, v1 = acc[ai][bj][m][1] * rs;
                    u32x4 w; w.x = cvtpk(v0[0], v0[1]); w.y = cvtpk(v0[2], v0[3]); w.z = cvtpk(v1[0], v1[1]); w.w = cvtpk(v1[2], v1[3]);
                    *(u32x4*)(base + (size_t)row * D + col0 + bj * HALF) = w;
                    if (t == 1) { const float mx = __builtin_fmaxf(__builtin_fmaxf(__builtin_fmaxf(__builtin_fabsf(v0[0]), __builtin_fabsf(v0[1])), __builtin_fmaxf(__builtin_fabsf(v0[2]), __builtin_fabsf(v0[3]))),
                                                              __builtin_fmaxf(__builtin_fmaxf(__builtin_fabsf(v1[0]), __builtin_fabsf(v1[1])), __builtin_fmaxf(__builtin_fabsf(v1[2]), __builtin_fabsf(v1[3]))));
                        if (bj == 0) kx0 = __builtin_fmaxf(kx0, mx); else kx1 = __builtin_fmaxf(kx1, mx); }
                }
            }
        if (t == 1) {
#pragma unroll
            for (int o = 1; o < 64; o <<= 1) { kx0 = __builtin_fmaxf(kx0, __shfl_xor(kx0, o)); kx1 = __builtin_fmaxf(kx1, __shfl_xor(kx1, o)); }
            if (fr == 0 && fq == 0) { unsigned* kp = kmax + (((u.pm >> 4) * 8 + (u.pn & 3) * 2) * 2 + (wc >> 1));
                atomicMax(kp, __float_as_uint(kx0)); atomicMax(kp + 2, __float_as_uint(kx1)); }
        }
    }
};

template <class Epi, class Sched, bool ALIGN_EPI, bool SHORT = false, bool BPRE = false>
__device__ __forceinline__ void gemm_phase(LAS unsigned char* lds, const Gemm g, const Sched& S, const Epi& E) {
    int tid_ = threadIdx.x; asm volatile("" : "+v"(tid_));
    const int tid = tid_, wid = __builtin_amdgcn_readfirstlane(tid >> 6), lane = tid & 63, wr = wid >> 2, wc = wid & 3, fr = lane & 15, fq = lane >> 4;
    const int K = g.K, nt = K / BK, lda = g.lda;
    unsigned voffA[2], voffB[2];
#pragma unroll
    for (int i = 0; i < 2; ++i) { int R, C; stage_rc(tid * 16 + i * 8192, R, C); const int Rb = Epi::PERM ? ((R & ~31) + perm32(R & 31)) : R;
        voffA[i] = (unsigned)((SHORT ? (R & 15) : R) * lda + C) * 2u; voffB[i] = (unsigned)(Rb * K + C) * 2u; }
    const size_t kstep = (size_t)(BK * 2);
    const size_t tstepA = (size_t)BM * lda * 2, hstepA = SHORT ? 0 : (size_t)HALF * lda * 2;
    const size_t hstepB = (size_t)HALF * K * 2, tstepB = 2 * hstepB;
    const size_t pnoffA = (size_t)g.a_pn_off * 2;
    const unsigned ldsdst = (unsigned)__builtin_amdgcn_readfirstlane((int)((unsigned)(uintptr_t)lds + (unsigned)wid * 1024u));
    const unsigned ldsssq = (unsigned)__builtin_amdgcn_readfirstlane((int)((unsigned)(uintptr_t)lds + (unsigned)SSQ_LDS + (unsigned)wid * 2048u));
    const int aoff = lds_byte(wr * 64 + fr, fq * 8), boff = lds_byte(wc * 32 + fr, fq * 8);
#define PG8_SA(b, h) (((b) * 2 + (h)) * HTB)
#define PG8_SB(b, h) ((4 + (b) * 2 + (h)) * HTB)
#define PG8_STAGE(bufoff, gbase, voff) do { _Pragma("unroll") for (int _i = 0; _i < 2; ++_i) \
        asm volatile("s_mov_b32 m0, %2\n\ts_nop 0\n\tglobal_load_lds_dwordx4 %0, %1" :: "v"((voff)[_i]), "s"((const char*)(gbase)), "s"(ldsdst + (unsigned)((bufoff) + _i * 8192)) : "memory"); } while (0)
#define PG8_LDA(dst, b, h) do { _Pragma("unroll") for (int m = 0; m < 4; ++m) _Pragma("unroll") for (int k = 0; k < 2; ++k) dst[m][k] = *(const LAS bf16x8*)(lds + PG8_SA(b, h) + aoff + m * 2048 + k * 1024); } while (0)
#define PG8_LDB(dst, b, h) do { _Pragma("unroll") for (int n = 0; n < 2; ++n) _Pragma("unroll") for (int k = 0; k < 2; ++k) dst[n][k] = *(const LAS bf16x8*)(lds + PG8_SB(b, h) + boff + n * 2048 + k * 1024); } while (0)
#define PG8_MMA(ai, bj, At, Bt) do { if constexpr (!SHORT) { __builtin_amdgcn_s_setprio(1); _Pragma("unroll") for (int m = 0; m < 4; ++m) _Pragma("unroll") for (int n = 0; n < 2; ++n) _Pragma("unroll") for (int k = 0; k < 2; ++k) \
        acc[ai][bj][m][n] = __builtin_amdgcn_mfma_f32_16x16x32_bf16(Bt[n][k], At[m][k], acc[ai][bj][m][n], 0, 0, 0); __builtin_amdgcn_s_setprio(0); } \
      else if ((ai) == 0) { if (wr == 0) { _Pragma("unroll") for (int n = 0; n < 2; ++n) _Pragma("unroll") for (int k = 0; k < 2; ++k) \
        acc[0][bj][0][n] = __builtin_amdgcn_mfma_f32_16x16x32_bf16(Bt[n][k], At[0][k], acc[0][bj][0][n], 0, 0, 0); } } } while (0)
#define PG8_WAIT_V(n) asm volatile("s_waitcnt vmcnt(" #n ")" ::: "memory")
#define PG8_WAIT_VN(n) asm volatile("s_waitcnt vmcnt(%0)" :: "n"(n) : "memory")
#define PG8_WAIT_L(n) asm volatile("s_waitcnt lgkmcnt(" #n ")" ::: "memory")
#define PG8_BAR __builtin_amdgcn_s_barrier()
#define PG8_SCHED __builtin_amdgcn_sched_barrier(0)
    Unit cur, nxt; int ui = 0;
    if (!S.next(0, cur)) return;
    f32x4 acc[2][2][4][2];
#pragma unroll
    for (int a = 0; a < 2; ++a)
#pragma unroll
        for (int b = 0; b < 2; ++b)
#pragma unroll
            for (int m = 0; m < 4; ++m)
#pragma unroll
                for (int n = 0; n < 2; ++n) acc[a][b][m][n] = (f32x4){0.f, 0.f, 0.f, 0.f};
    bf16x8 At[4][2], B0[2][2], B1[2][2];
    const char* cA = (const char*)g.A + (size_t)cur.pm * tstepA + (size_t)cur.pn * pnoffA; const char* cB = (const char*)g.Bt + (size_t)cur.pn * tstepB;
    if constexpr (!BPRE) { PG8_STAGE(PG8_SB(0, 0), cB, voffB); PG8_STAGE(PG8_SB(0, 1), cB + hstepB, voffB); } PG8_STAGE(PG8_SA(0, 0), cA, voffA); PG8_STAGE(PG8_SA(0, 1), cA + hstepA, voffA);
    if (wr == 1) PG8_BAR;
    PG8_WAIT_V(2); PG8_BAR;
    if constexpr (!BPRE) PG8_STAGE(PG8_SB(1, 0), cB + kstep, voffB); PG8_STAGE(PG8_SA(1, 0), cA + kstep, voffA); if constexpr (!BPRE) PG8_STAGE(PG8_SB(1, 1), cB + hstepB + kstep, voffB);
    if constexpr (!SHORT) PG8_STAGE(PG8_SA(1, 1), cA + kstep + hstepA, voffA);
    if constexpr (SHORT) PG8_WAIT_V(6); else PG8_WAIT_V(0);
    PG8_BAR;
    for (;;) {
        const bool has_next = S.next(ui + 1, nxt);
        const char* nA = has_next ? (const char*)g.A + (size_t)nxt.pm * tstepA + (size_t)nxt.pn * pnoffA : cA; const char* nB = has_next ? (const char*)g.Bt + (size_t)nxt.pn * tstepB : cB;
#define PG8_SSQ(ON) do { if constexpr (Epi::RSTD_LDS && !SHORT) { if (ON) { const char* sb_ = (const char*)(E.ssq + (size_t)cur.pm * (BM * 16)); \
            _Pragma("unroll") for (int _i = 0; _i < 2; ++_i) asm volatile("s_mov_b32 m0, %2\n\ts_nop 0\n\tglobal_load_lds_dwordx4 %0, %1" :: "v"((unsigned)(wid * 2048 + _i * 1024 + lane * 16)), "s"(sb_), "s"(ldsssq + (unsigned)(_i * 1024)) : "memory"); } } } while (0)
#define PG8_ITER(W1, W2, W3, W4, STG11) do { \
            const bool last = (t == nt - 2); \
            const char* a1 = cA + (size_t)(t + 1) * kstep; \
            const char* a2 = last ? nA : cA + (size_t)(t + 2) * kstep; const char* b2 = last ? nB : cB + (size_t)(t + 2) * kstep; \
            const char* a3 = a2 + kstep; const char* b3 = b2 + kstep; \
              \
            PG8_LDB(B0, 0, 0); PG8_LDB(B1, 0, 1); PG8_SCHED; PG8_LDA(At, 0, 0); if (STG11) PG8_STAGE(PG8_SA(1, 1), a1 + hstepA, voffA); \
            PG8_WAIT_VN(W1); PG8_WAIT_L(0); PG8_BAR; PG8_MMA(0, 0, At, B0); PG8_MMA(0, 1, At, B1); PG8_BAR; PG8_SCHED; \
              \
            PG8_LDA(At, 0, 1); PG8_STAGE(PG8_SB(0, 0), b2, voffB); PG8_STAGE(PG8_SB(0, 1), b2 + hstepB, voffB); PG8_STAGE(PG8_SA(0, 0), a2, voffA); PG8_SSQ(!(STG11)); \
            PG8_WAIT_VN(W2); PG8_WAIT_L(0); PG8_BAR; PG8_MMA(1, 0, At, B0); PG8_MMA(1, 1, At, B1); PG8_BAR; PG8_SCHED; \
              \
            PG8_LDB(B0, 1, 0); PG8_LDB(B1, 1, 1); PG8_SCHED; PG8_LDA(At, 1, 0); PG8_STAGE(PG8_SA(0, 1), a2 + hstepA, voffA); \
            PG8_WAIT_VN(W3); PG8_WAIT_L(0); PG8_BAR; PG8_MMA(0, 0, At, B0); PG8_MMA(0, 1, At, B1); PG8_BAR; PG8_SCHED; \
              \
            PG8_LDA(At, 1, 1); PG8_STAGE(PG8_SB(1, 0), b3, voffB); PG8_STAGE(PG8_SB(1, 1), b3 + hstepB, voffB); PG8_STAGE(PG8_SA(1, 0), a3, voffA); \
            PG8_WAIT_VN(W4); PG8_WAIT_L(0); PG8_BAR; PG8_MMA(1, 0, At, B0); PG8_MMA(1, 1, At, B1); PG8_BAR; PG8_SCHED; } while (0)
        if constexpr (!SHORT) { { const int t = 0; constexpr int X = (Epi::RSTD_LDS ? 2 : 0);
              PG8_ITER(Epi::NSTORES + 2, Epi::NSTORES + 8 + X, Epi::NSTORES + 10 + X, Epi::NSTORES + 14 + X, false); }
            for (int t = 2; t < nt; t += 2) PG8_ITER(8, 8, 8, 8, true);
            PG8_STAGE(PG8_SA(1, 1), nA + kstep + hstepA, voffA); }
        else { for (int t = 0; t < nt; t += 2) PG8_ITER(8, 8, 8, 8, true); }
#undef PG8_ITER
#undef PG8_SSQ
        if constexpr (ALIGN_EPI) { if (wr == 0) PG8_BAR; }
        E(acc, cur, wr, wc, fr, fq);
        if (!has_next) break;
#pragma unroll
        for (int a = 0; a < 2; ++a)
#pragma unroll
            for (int b = 0; b < 2; ++b)
#pragma unroll
                for (int m = 0; m < 4; ++m)
#pragma unroll
                    for (int n = 0; n < 2; ++n) acc[a][b][m][n] = (f32x4){0.f, 0.f, 0.f, 0.f};
        cur = nxt; cA = nA; cB = nB; ++ui;
        if constexpr (ALIGN_EPI) { if (wr == 1) PG8_BAR; }
    }
    PG8_WAIT_V(0);
    if constexpr (!ALIGN_EPI) { if (wr == 0) PG8_BAR; }
    PG8_BAR;
#undef PG8_SA
#undef PG8_SB
#undef PG8_STAGE
#undef PG8_LDA
#undef PG8_LDB
#undef PG8_MMA
#undef PG8_WAIT_V
#undef PG8_WAIT_VN
#undef PG8_WAIT_L
#undef PG8_BAR
#undef PG8_SCHED
}
template <class Epi, class Sched>
__device__ __forceinline__ void prefetch_b(LAS unsigned char* lds, const Gemm g, const Sched& S) {
    int tid_ = threadIdx.x; asm volatile("" : "+v"(tid_));
    const int tid = tid_, wid = __builtin_amdgcn_readfirstlane(tid >> 6);
    Unit u; if (!S.next(0, u)) return;
    const int K = g.K;
    const size_t hstepB = (size_t)HALF * K * 2, kstep = (size_t)(BK * 2);
    const char* cB = (const char*)g.Bt + (size_t)u.pn * (2 * hstepB);
    const unsigned ldsdst = (unsigned)__builtin_amdgcn_readfirstlane((int)((unsigned)(uintptr_t)lds + (unsigned)wid * 1024u));
#pragma unroll
    for (int i = 0; i < 2; ++i) { int R, C; stage_rc(tid * 16 + i * 8192, R, C); const int Rb = Epi::PERM ? ((R & ~31) + perm32(R & 31)) : R;
        const unsigned vo = (unsigned)(Rb * K + C) * 2u;
#pragma unroll
        for (int q = 0; q < 4; ++q) {
            const char* src = cB + (q & 1) * hstepB + (q >> 1) * kstep;
            asm volatile("s_mov_b32 m0, %2\n\ts_nop 0\n\tglobal_load_lds_dwordx4 %0, %1" :: "v"(vo), "s"(src), "s"(ldsdst + (unsigned)((4 + (q >> 1) * 2 + (q & 1)) * HTB + i * 8192)) : "memory"); } }
}
}

namespace att {
typedef LAS const char* lds_cptr;
typedef short v4i16_t __attribute__((ext_vector_type(4)));
constexpr int PITCH = 1024, QB = 128, KVB = 64;
constexpr int KSLOT = 16384, VSLOT = 16384;
constexpr int LDS_V = 3 * KSLOT;
constexpr int LDS_TAB = LDS_V + 3 * VSLOT;
constexpr int LDS_WSF = LDS_TAB + 1152;
constexpr int THR = 8, FIXTHR = 80;
__device__ __forceinline__ int crow(int r, int hi) { return (r & 3) + 8 * (r >> 2) + 4 * hi; }
__device__ __forceinline__ void glds16(const void* gsrc, unsigned lds_dst) { unsigned keep;
    asm volatile("s_mov_b32 %0, m0\n\ts_mov_b32 m0, %2\n\ts_nop 0\n\tglobal_load_lds_dwordx4 %1, off\n\ts_mov_b32 m0, %0" : "=&s"(keep) : "v"(gsrc), "s"(lds_dst) : "memory"); }
__device__ __forceinline__ s16x4 vtr(lds_cptr p) { return __builtin_bit_cast(s16x4, __builtin_amdgcn_ds_read_tr16_b64_v4i16((LAS v4i16_t*)p)); }
#define ATT_WAIT_BAR() asm volatile("s_waitcnt vmcnt(0) lgkmcnt(0)\n\ts_barrier" ::: "memory")
#define ATT_LBAR() asm volatile("s_waitcnt lgkmcnt(0)\n\ts_barrier" ::: "memory")
#define MX3(a, b, c) __builtin_fmaxf(__builtin_fmaxf((a), (b)), (c))
__device__ __forceinline__ float rowmax(const f32x16& p0, const f32x16& p1) {
    float a = MX3(p0[0], p0[1], p1[0]), b = MX3(p0[2], p0[3], p1[1]); a = MX3(a, p1[2], p1[3]);
#pragma unroll
    for (int r = 4; r < 16; r += 4) { a = MX3(a, p0[r], p0[r + 1]); b = MX3(b, p0[r + 2], p0[r + 3]); a = MX3(a, p1[r], p1[r + 1]); b = MX3(b, p1[r + 2], p1[r + 3]); }
    const float m = __builtin_fmaxf(a, b); auto rr = __builtin_amdgcn_permlane32_swap(__float_as_uint(m), __float_as_uint(m), false, false);
    return __builtin_fmaxf(__uint_as_float(rr[0]), __uint_as_float(rr[1]));
}
__device__ __forceinline__ int t5_bucket(int rel) {
    if (rel < 16) return rel;
    int b = 16;
    b += rel >= 19; b += rel >= 21; b += rel >= 24; b += rel >= 27; b += rel >= 31; b += rel >= 35; b += rel >= 40; b += rel >= 46;
    b += rel >= 52; b += rel >= 59; b += rel >= 67; b += rel >= 77; b += rel >= 87; b += rel >= 99; b += rel >= 113;
    return b;
}

__device__ __forceinline__ void attn_unit(int b, int h, int qb, const bf16_t* Q, const bf16_t* K, const bf16_t* V, bf16_t* O, LAS unsigned char* shm,
                                          const float* rel_bias, const float* subg, float lam, unsigned* kmax) {
    int tid_ = threadIdx.x; asm volatile("" : "+v"(tid_));
    const int tid = tid_, lane = tid & 63, r32 = lane & 31, hi = lane >> 5; const int wid = __builtin_amdgcn_readfirstlane(tid >> 6);
    const int mp = wid >> 2, wq = wid & 3;
    const int q0 = qb * QB, qw0 = q0 + 32 * wq;
    const long rowb = (long)b * SEQ;
    const unsigned lds0 = (unsigned)(uintptr_t)shm;
    LAS float* wsf = (LAS float*)(shm + LDS_WSF) + wid * 64;
    LAS float* tab = (LAS float*)(shm + LDS_TAB);
    const float cb = rel_bias[31 * NH + h] * LOG2E;
    if (tid < 288) { const int rel = tid - 64; tab[tid] = rel < 0 ? -INFINITY : (rel < 128 ? (rel_bias[t5_bucket(rel) * NH + h] - rel_bias[31 * NH + h]) * LOG2E : 0.f); }
#define ATT_ISSUE_K(t, koff) do { \
        const long krow_ = ((t) == 0) ? (long)META0 : rowb + 64 * ((t) - 1); \
        const bf16_t* ks_ = K + (krow_ + lane) * PITCH + h * 128 + wid * 8; \
        glds16(ks_, (unsigned)__builtin_amdgcn_readfirstlane(lds0 + (koff) + wid * 1024)); \
        glds16(ks_ + 64, (unsigned)__builtin_amdgcn_readfirstlane(lds0 + (koff) + 8192 + wid * 1024)); } while (0)
#define ATT_ISSUE_V(t, voff) do { \
        const long vrow_ = ((t) == 0) ? (long)META0 : rowb + 64 * ((t) - 1); \
        const bf16_t* vs_ = V + (vrow_ + 16 * (wid & 3) + (lane >> 2)) * PITCH + h * 128 + 32 * (wid >> 2) + (lane & 3) * 8; \
        glds16(vs_, (unsigned)__builtin_amdgcn_readfirstlane(lds0 + LDS_V + (voff) + wid * 1024)); \
        glds16(vs_ + 64, (unsigned)__builtin_amdgcn_readfirstlane(lds0 + LDS_V + (voff) + 8192 + wid * 1024)); } while (0)
    const int NT = 1 + 2 * (qb + 1);
    ATT_ISSUE_K(0, 0); ATT_ISSUE_V(0, 0); ATT_ISSUE_K(1, KSLOT); ATT_ISSUE_V(1, VSLOT); ATT_ISSUE_K(2, 2 * KSLOT);
    bf16x8 qr[4];
    { const bf16_t* Qw = Q + (rowb + qw0 + r32) * PITCH + h * 128 + mp * 64 + hi * 8;
#pragma unroll
      for (int d0 = 0; d0 < 4; ++d0) qr[d0] = *(const bf16x8*)(Qw + d0 * 16); }
    const unsigned kmx_a = __hip_atomic_load(kmax + (b * 8 + h) * 2 + mp, __ATOMIC_RELAXED, __HIP_MEMORY_SCOPE_AGENT), kmx_b = __hip_atomic_load(kmax + 128 + h * 2 + mp, __ATOMIC_RELAXED, __HIP_MEMORY_SCOPE_AGENT);
    const float bv_raw = rel_bias[(lane & 31) * NH + h];
    float mhat = 0.f, l_reg = 0.f;
    f32x16 o[4];
#pragma unroll
    for (int vb = 0; vb < 4; ++vb) o[vb] = f32x16{};
    f32x16 cinit;
#pragma unroll
    for (int r = 0; r < 16; ++r) cinit[r] = cb;
    const lds_cptr shm3 = (lds_cptr)shm;
    const lds_cptr kp0 = shm3 + mp * 8192 + hi * 1024 + r32 * 16;
    const lds_cptr vp0 = shm3 + LDS_V + ((lane >> 4) & 1) * 32 + (lane & 3) * 8 + (4 * hi + ((lane & 15) >> 2)) * 64;
#define SBAR() __builtin_amdgcn_sched_barrier(0)
#define PIN(x) asm volatile("" : "+v"(x))
#define MFMA(a, b, c) __builtin_amdgcn_mfma_f32_32x32x16_bf16(a, b, c, 0, 0, 0)
#define KFR(j) (*(const LAS bf16x8*)(kp_ + ((j) >> 1) * 2048 + ((j) & 1) * 512))
#define KRD(F, j) do { if (F) kf##j = KFR(j); } while (0)
#define PKW(P, B) cvtpk(P[B], P[(B) + 1])
#define EX(v) __builtin_amdgcn_exp2f(v)
#define VRD(dst, h) do { dst[0] = vtr(vp_ + ((h) >> 2) * 4096 + ((h) & 3) * 1024); dst[1] = vtr(vp_ + ((h) >> 2) * 4096 + ((h) & 3) * 1024 + 512); } while (0)
#define VFRAG(src) ((bf16x8){src[0][0], src[0][1], src[0][2], src[0][3], src[1][0], src[1][1], src[1][2], src[1][3]})
#define PAF(k) __builtin_bit_cast(bf16x8, pw##k)
#define GAPA(MF, A0, A1, A2, A3, W0, W1, PW) do { MF; sacc += A0; sacc += A1; sacc += A2; sacc += A3; PIN(sacc); W0; W1; PIN(PW); SBAR(); } while (0)
#define GAPB(VR, KR, MF, X, B) do { VR; KR; MF; X[B] = EX(X[B]); X[(B) + 1] = EX(X[(B) + 1]); PIN(X); SBAR(); } while (0)
#define GAPB0(VR, KR, MF) do { VR; KR; MF; SBAR(); } while (0)
    u32x4 pw0, pw1, pw2, pw3;
    bf16x8 kf0, kf1, kf2, kf3, kf4, kf5, kf6, kf7;
    bool resc = false;
#define PHASE_A(C0, C1, P0, P1, t, DOQK) do { SBAR(); float sacc = P0[0] + P0[1]; \
        if (DOQK) { \
            GAPA(C0 = MFMA(kf0, qr[0], cinit), P0[2], P0[3], P0[4], P0[5],     pw0[0] = PKW(P0, 0),  pw0[1] = PKW(P0, 2),  pw0); \
            GAPA(C1 = MFMA(kf1, qr[0], cinit), P0[6], P0[7], P0[8], P0[9],     pw0[2] = PKW(P0, 4),  pw0[3] = PKW(P0, 6),  pw0); \
            GAPA(C0 = MFMA(kf2, qr[1], C0),    P0[10], P0[11], P0[12], P0[13], pw1[0] = PKW(P0, 8),  pw1[1] = PKW(P0, 10), pw1); \
            GAPA(C1 = MFMA(kf3, qr[1], C1),    P0[14], P0[15], P1[0], P1[1],   pw1[2] = PKW(P0, 12), pw1[3] = PKW(P0, 14), pw1); \
            GAPA(C0 = MFMA(kf4, qr[2], C0),    P1[2], P1[3], P1[4], P1[5],     pw2[0] = PKW(P1, 0),  pw2[1] = PKW(P1, 2),  pw2); \
            GAPA(C1 = MFMA(kf5, qr[2], C1),    P1[6], P1[7], P1[8], P1[9],     pw2[2] = PKW(P1, 4),  pw2[3] = PKW(P1, 6),  pw2); \
            GAPA(C0 = MFMA(kf6, qr[3], C0),    P1[10], P1[11], P1[12], P1[13], pw3[0] = PKW(P1, 8),  pw3[1] = PKW(P1, 10), pw3); \
            GAPA(C1 = MFMA(kf7, qr[3], C1),    P1[14], P1[15], 0.f, 0.f,       pw3[2] = PKW(P1, 12), pw3[3] = PKW(P1, 14), pw3); \
        } else { \
            _Pragma("unroll") for (int r = 2; r < 16; ++r) sacc += P0[r]; _Pragma("unroll") for (int r = 0; r < 16; ++r) sacc += P1[r]; \
            pw0 = (u32x4){PKW(P0, 0), PKW(P0, 2), PKW(P0, 4), PKW(P0, 6)}; pw1 = (u32x4){PKW(P0, 8), PKW(P0, 10), PKW(P0, 12), PKW(P0, 14)}; \
            pw2 = (u32x4){PKW(P1, 0), PKW(P1, 2), PKW(P1, 4), PKW(P1, 6)}; pw3 = (u32x4){PKW(P1, 8), PKW(P1, 10), PKW(P1, 12), PKW(P1, 14)}; } \
        l_reg += sacc; } while (0)
#define MIDDLE(C0, C1, t) do { const int kfirst = 64 * ((t) - 1); \
        if (kfirst + 63 + 113 > qw0) { const LAS float* tb = tab + (64 + qw0 + r32 - kfirst - 4 * hi - 63); \
            _Pragma("unroll") for (int r = 0; r < 16; ++r) { const int c = (r & 3) + 8 * (r >> 2); C0[r] += ((volatile const LAS float*)tb)[63 - c]; C1[r] += ((volatile const LAS float*)tb)[31 - c]; } } \
        resc = false; \
        if (!fixedref) { const float rm = rowmax(C0, C1); \
        if (__builtin_expect(__any(rm > (float)THR), 0)) { const float dl = __builtin_fmaxf(rm, 0.f); mhat += dl; \
            _Pragma("unroll") for (int r = 0; r < 16; ++r) { C0[r] -= dl; C1[r] -= dl; cinit[r] -= dl; } \
            const float f = __builtin_amdgcn_exp2f(-dl); l_reg *= f; if (hi == 0) wsf[r32] = f; resc = true; } } } while (0)
#define PHASE_B(X0, X1, vso, DOEX, RDK) do { SBAR(); const lds_cptr vp_ = vp0 + (vso); const lds_cptr kp_ = kp0 + ks_rd; s16x4 vA[2], vB[2], vC[2]; VRD(vA, 0); VRD(vB, 1); SBAR(); \
        if (DOEX) { \
            GAPB(VRD(vC, 2),  (void)0, o[0] = MFMA(PAF(0), VFRAG(vA), o[0]), X0, 0);  GAPB(VRD(vA, 3),  (void)0, o[0] = MFMA(PAF(1), VFRAG(vB), o[0]), X0, 2); \
            GAPB(VRD(vB, 4),  KRD(RDK, 0),  o[0] = MFMA(PAF(2), VFRAG(vC), o[0]), X0, 4);  GAPB(VRD(vC, 5),  KRD(RDK, 1),  o[0] = MFMA(PAF(3), VFRAG(vA), o[0]), X0, 6); \
            GAPB(VRD(vA, 6),  KRD(RDK, 2),  o[1] = MFMA(PAF(0), VFRAG(vB), o[1]), X0, 8);  GAPB(VRD(vB, 7),  KRD(RDK, 3),  o[1] = MFMA(PAF(1), VFRAG(vC), o[1]), X0, 10); \
            GAPB(VRD(vC, 8),  KRD(RDK, 4),  o[1] = MFMA(PAF(2), VFRAG(vA), o[1]), X0, 12); GAPB(VRD(vA, 9),  KRD(RDK, 5),  o[1] = MFMA(PAF(3), VFRAG(vB), o[1]), X0, 14); \
            GAPB(VRD(vB, 10), KRD(RDK, 6),  o[2] = MFMA(PAF(0), VFRAG(vC), o[2]), X1, 0);  GAPB(VRD(vC, 11), KRD(RDK, 7),  o[2] = MFMA(PAF(1), VFRAG(vA), o[2]), X1, 2); \
            GAPB(VRD(vA, 12), (void)0, o[2] = MFMA(PAF(2), VFRAG(vB), o[2]), X1, 4);  GAPB(VRD(vB, 13), (void)0, o[2] = MFMA(PAF(3), VFRAG(vC), o[2]), X1, 6); \
            GAPB(VRD(vC, 14), (void)0, o[3] = MFMA(PAF(0), VFRAG(vA), o[3]), X1, 8);  GAPB(VRD(vA, 15), (void)0, o[3] = MFMA(PAF(1), VFRAG(vB), o[3]), X1, 10); \
            GAPB((void)0,     (void)0, o[3] = MFMA(PAF(2), VFRAG(vC), o[3]), X1, 12); GAPB((void)0,     (void)0, o[3] = MFMA(PAF(3), VFRAG(vA), o[3]), X1, 14); \
        } else { \
            GAPB0(VRD(vC, 2),  (void)0, o[0] = MFMA(PAF(0), VFRAG(vA), o[0])); GAPB0(VRD(vA, 3),  (void)0, o[0] = MFMA(PAF(1), VFRAG(vB), o[0])); \
            GAPB0(VRD(vB, 4),  KRD(RDK, 0),  o[0] = MFMA(PAF(2), VFRAG(vC), o[0])); GAPB0(VRD(vC, 5),  KRD(RDK, 1),  o[0] = MFMA(PAF(3), VFRAG(vA), o[0])); \
            GAPB0(VRD(vA, 6),  KRD(RDK, 2),  o[1] = MFMA(PAF(0), VFRAG(vB), o[1])); GAPB0(VRD(vB, 7),  KRD(RDK, 3),  o[1] = MFMA(PAF(1), VFRAG(vC), o[1])); \
            GAPB0(VRD(vC, 8),  KRD(RDK, 4),  o[1] = MFMA(PAF(2), VFRAG(vA), o[1])); GAPB0(VRD(vA, 9),  KRD(RDK, 5),  o[1] = MFMA(PAF(3), VFRAG(vB), o[1])); \
            GAPB0(VRD(vB, 10), KRD(RDK, 6),  o[2] = MFMA(PAF(0), VFRAG(vC), o[2])); GAPB0(VRD(vC, 11), KRD(RDK, 7),  o[2] = MFMA(PAF(1), VFRAG(vA), o[2])); \
            GAPB0(VRD(vA, 12), (void)0, o[2] = MFMA(PAF(2), VFRAG(vB), o[2])); GAPB0(VRD(vB, 13), (void)0, o[2] = MFMA(PAF(3), VFRAG(vC), o[2])); \
            GAPB0(VRD(vC, 14), (void)0, o[3] = MFMA(PAF(0), VFRAG(vA), o[3])); GAPB0(VRD(vA, 15), (void)0, o[3] = MFMA(PAF(1), VFRAG(vB), o[3])); \
            GAPB0((void)0,     (void)0, o[3] = MFMA(PAF(2), VFRAG(vC), o[3])); GAPB0((void)0,     (void)0, o[3] = MFMA(PAF(3), VFRAG(vA), o[3])); \
        } } while (0)
#define RESC() do { if (resc) { asm volatile("s_waitcnt lgkmcnt(0)" ::: "memory"); \
        _Pragma("unroll") for (int r = 0; r < 16; ++r) { const float fr_ = wsf[crow(r, hi)]; \
            _Pragma("unroll") for (int vb = 0; vb < 4; ++vb) o[vb][r] *= fr_; } } } while (0)
    int vs_prev = 0, vs_next = 2 * VSLOT;
    int ks_rd = 2 * KSLOT, ks_is = 0;
#define ROT() do { vs_prev = (vs_prev == 2 * VSLOT) ? 0 : vs_prev + VSLOT; vs_next = (vs_next == 2 * VSLOT) ? 0 : vs_next + VSLOT; \
        ks_rd = ks_is; ks_is = (ks_is == 2 * KSLOT) ? 0 : ks_is + KSLOT; } while (0)
#define STEP(C0, C1, P0, P1, t, DOQK, RDK) do { \
        if ((t) + 2 < NT) ATT_ISSUE_K((t) + 2, ks_is);     \
        if ((t) + 1 < NT) ATT_ISSUE_V((t) + 1, vs_next);   \
        PHASE_A(C0, C1, P0, P1, t, DOQK); \
        if (DOQK) { MIDDLE(C0, C1, t); } else resc = false; \
        PHASE_B(C0, C1, vs_prev, DOQK, RDK); \
        ATT_WAIT_BAR(); RESC(); ROT(); } while (0)
    f32x16 sA0, sA1, sB0, sB1;
    ATT_WAIT_BAR();
    { const lds_cptr kp_ = kp0; sA0 = cinit;
#pragma unroll
      for (int d0 = 0; d0 < 4; ++d0) sA0 = MFMA(KFR(2 * d0), qr[d0], sA0);
      if (q0 == 0) { const LAS float* tb = tab + (64 + qw0 + r32 + NMETA - 4 * hi - 11);
#pragma unroll
          for (int r = 0; r < 8; ++r) sA0[r] += ((volatile const LAS float*)tb)[11 - ((r & 3) + 8 * (r >> 2))]; }
      float a = MX3(sA0[0], sA0[1], sA0[2]), bq = MX3(sA0[3], sA0[4], sA0[5]); a = MX3(a, sA0[6], sA0[7]); float rm = __builtin_fmaxf(a, bq);
      { auto rr = __builtin_amdgcn_permlane32_swap(__float_as_uint(rm), __float_as_uint(rm), false, false); rm = __builtin_fmaxf(__uint_as_float(rr[0]), __uint_as_float(rr[1])); }
      mhat = rm;
#pragma unroll
      for (int r = 0; r < 16; ++r) cinit[r] -= rm;
#pragma unroll
      for (int r = 0; r < 8; ++r) sA0[r] = EX(sA0[r] - rm);
#pragma unroll
      for (int r = 8; r < 16; ++r) sA0[r] = 0.f;
#pragma unroll
      for (int r = 0; r < 16; ++r) sA1[r] = 0.f;
      { const lds_cptr kp_ = kp0 + KSLOT; kf0 = KFR(0); kf1 = KFR(1); kf2 = KFR(2); kf3 = KFR(3); kf4 = KFR(4); kf5 = KFR(5); kf6 = KFR(6); kf7 = KFR(7); } }
    ATT_WAIT_BAR();
    const bool last_act = (wq >= 2);
    bool fixedref;
    { float q1 = 0.f;
#pragma unroll
      for (int d0 = 0; d0 < 4; ++d0)
#pragma unroll
          for (int e = 0; e < 8; ++e) q1 += __builtin_fabsf(__uint_as_float(((unsigned)(unsigned short)qr[d0][e]) << 16));
      { auto rr = __builtin_amdgcn_permlane32_swap(__float_as_uint(q1), __float_as_uint(q1), false, false); q1 = __uint_as_float(rr[0]) + __uint_as_float(rr[1]); }
      const float kmx = __builtin_fmaxf(__uint_as_float(kmx_a), __uint_as_float(kmx_b)) * 1.01f;
      float bv = (lane < 32) ? bv_raw * LOG2E : -INFINITY;
#pragma unroll
      for (int o = 1; o < 32; o <<= 1) bv = __builtin_fmaxf(bv, __shfl_xor(bv, o));
      const float bmax = __shfl(bv, 0);
      fixedref = __all(q1 * kmx + bmax - mhat <= (float)FIXTHR) != 0; }
    int t = 1;
    for (; t + 2 < NT; t += 2) {
        STEP(sB0, sB1, sA0, sA1, t, true, true);
        STEP(sA0, sA1, sB0, sB1, t + 1, true, true);
    }
    STEP(sB0, sB1, sA0, sA1, t, true, true);
    STEP(sA0, sA1, sB0, sB1, t + 1, last_act, false);
    if (last_act) { resc = false; PHASE_A(sB0, sB1, sA0, sA1, NT, false); PHASE_B(sB0, sB1, vs_prev, false, false); }
#undef STEP
#undef ROT
#undef RESC
#undef PHASE_B
#undef MIDDLE
#undef PHASE_A
#undef GAPB0
#undef GAPB
#undef GAPA
#undef PAF
#undef VFRAG
#undef VRD
#undef EX
#undef PKW
#undef KFR
#undef MFMA
#undef PIN
#undef SBAR
#undef ATT_ISSUE_K
#undef ATT_ISSUE_V
#undef KRD
    { auto rr = __builtin_amdgcn_permlane32_swap(__float_as_uint(l_reg), __float_as_uint(l_reg), false, false); l_reg = __uint_as_float(rr[0]) + __uint_as_float(rr[1]); }
    if (hi == 0) wsf[32 + r32] = l_reg;
    asm volatile("s_waitcnt lgkmcnt(0)" ::: "memory");
    const float msc = mp ? lam : 1.0f;
    float rli[16];
#pragma unroll
    for (int r = 0; r < 16; ++r) rli[r] = msc * __builtin_amdgcn_rcpf(wsf[32 + crow(r, hi)]);
    ATT_WAIT_BAR();
    { LAS float* stg = (LAS float*)shm + mp * (QB * 128) + (32 * wq) * 128 + r32;
#pragma unroll
      for (int vb = 0; vb < 4; ++vb)
#pragma unroll
          for (int r = 0; r < 16; ++r) stg[crow(r, hi) * 128 + 32 * vb] = o[vb][r] * rli[r]; }
    ATT_LBAR();
    { const int row = tid >> 2, seg = tid & 3;
      const LAS f32x4* a = (const LAS f32x4*)((LAS float*)shm + row * 128 + seg * 32);
      const LAS f32x4* c = (const LAS f32x4*)((LAS float*)shm + QB * 128 + row * 128 + seg * 32);
      f32x4 dv[8]; float ss = 0.f;
#pragma unroll
      for (int i = 0; i < 8; ++i) { dv[i] = a[i] - c[i]; ss += (dv[i][0] * dv[i][0] + dv[i][1] * dv[i][1]) + (dv[i][2] * dv[i][2] + dv[i][3] * dv[i][3]); }
      ss += __shfl_xor(ss, 1); ss += __shfl_xor(ss, 2);
      const float rs = __builtin_amdgcn_rsqf(ss * (1.0f / 128.0f) + RMS_EPS) * (1.0f - LAMBDA_INIT);
      bf16_t* op = O + (rowb + q0 + row) * PITCH + h * 128 + seg * 32;
      const f32x4* gp = (const f32x4*)(subg + seg * 32);
#pragma unroll
      for (int i = 0; i < 4; ++i) { const f32x4 g0 = gp[2 * i], g1 = gp[2 * i + 1]; const f32x4 v0 = dv[2 * i] * rs * g0, v1 = dv[2 * i + 1] * rs * g1;
          u32x4 w; w.x = cvtpk(v0[0], v0[1]); w.y = cvtpk(v0[2], v0[3]); w.z = cvtpk(v1[0], v1[1]); w.w = cvtpk(v1[2], v1[3]);
          *(u32x4*)(op + 8 * i) = w; } }
    ATT_LBAR();
}
#undef MX3
}

namespace mrow {
template <int NB, int KSTEPS>
__device__ __forceinline__ bool partial_reduce(const bf16_t* A, int lda, const bf16_t* Bt, int K, const int (&nrow)[NB], int wave, int lane, LAS f32x4* red, f32x4 (&acc)[NB]) {
    const int fr = lane & 15, fq = lane >> 4;
    const size_t koff = (size_t)wave * (KSTEPS * 32) + fq * 8;
    const bf16_t* ap = A + (size_t)fr * lda + koff;
#pragma unroll
    for (int nb = 0; nb < NB; ++nb) acc[nb] = (f32x4){0.f, 0.f, 0.f, 0.f};
    constexpr int CH = 4;
#pragma unroll
    for (int s0 = 0; s0 < KSTEPS; s0 += CH) {
        bf16x8 a[CH], b[NB][CH];
#pragma unroll
        for (int c = 0; c < CH; ++c) if (s0 + c < KSTEPS) a[c] = *(const bf16x8*)(ap + (s0 + c) * 32);
#pragma unroll
        for (int nb = 0; nb < NB; ++nb)
#pragma unroll
            for (int c = 0; c < CH; ++c) if (s0 + c < KSTEPS) b[nb][c] = *(const bf16x8*)(Bt + (size_t)(nrow[nb] + fr) * K + koff + (s0 + c) * 32);
#pragma unroll
        for (int nb = 0; nb < NB; ++nb)
#pragma unroll
            for (int c = 0; c < CH; ++c) if (s0 + c < KSTEPS) acc[nb] = __builtin_amdgcn_mfma_f32_16x16x32_bf16(b[nb][c], a[c], acc[nb], 0, 0, 0);
        __builtin_amdgcn_sched_barrier(0);
    }
#pragma unroll
    for (int nb = 0; nb < NB; ++nb) red[(wave * NB + nb) * 64 + lane] = acc[nb];
    __syncthreads();
    if (wave != 0) return false;
#pragma unroll
    for (int nb = 0; nb < NB; ++nb) { f32x4 t = red[nb * 64 + lane];
#pragma unroll
        for (int w = 1; w < 8; ++w) t += red[(w * NB + nb) * 64 + lane];
        acc[nb] = t; }
    return true;
}
}

#ifndef REP_GU
#define REP_GU 1
#endif
#ifndef REP_MISC
#define REP_MISC 1
#endif
#ifndef REP_P5
#define REP_P5 1
#endif
#ifndef PHASE_MASK
#define PHASE_MASK 0x3ff
#endif
constexpr int NWAVES = 8;
constexpr size_t MiB = 1u << 20;
constexpr size_t WS_CTL = 0, CTL_ZERO_BYTES = 1 * MiB;
constexpr size_t WS_WPOOL = 1 * MiB, WS_WGU0 = 2 * MiB, WS_WD0 = 13 * MiB, WS_WQKV = 19 * MiB, WS_WO = 25 * MiB, WS_WGU1 = 27 * MiB, WS_WD1 = 38 * MiB;
constexpr size_t WS_SSQ = 44 * MiB;
constexpr size_t WS_H = 48 * MiB;
constexpr size_t WS_HB = 178 * MiB;
constexpr size_t WS_ACT = 243 * MiB;
constexpr size_t QKV_STRIDE = (size_t)MPAD * D;
constexpr size_t WS_O = 437 * MiB;
constexpr size_t WS_END = 502 * MiB;
static_assert(WS_WGU0 + (size_t)2 * FF * D * 2 <= WS_WD0 && WS_WD0 + (size_t)FF * D * 2 <= WS_WQKV && WS_WQKV + (size_t)3 * D * D * 2 <= WS_WO && WS_WO + (size_t)D * D * 2 <= WS_WGU1, "ws map");
static_assert(WS_WGU1 + (size_t)2 * FF * D * 2 <= WS_WD1 && WS_WD1 + (size_t)FF * D * 2 <= WS_SSQ && WS_SSQ + (size_t)MPAD * 16 * 4 <= WS_H && WS_H + (size_t)MPAD * D * 4 <= WS_HB, "ws map");
static_assert(WS_HB + (size_t)MPAD * D * 2 <= WS_ACT && WS_ACT + (size_t)MPAD * FF * 2 <= WS_END && WS_ACT + 3 * QKV_STRIDE * 2 <= WS_O && WS_O + (size_t)MMAIN * D * 2 <= WS_END, "ws map");
constexpr int CW_BAR = 4096;
constexpr int CW_KMAX = 65536;

constexpr int RING_OFF = 0, RING_BYTES = 131072;
constexpr int LDSCTL_OFF = RING_BYTES, MISC_OFF = LDSCTL_OFF + 320;
constexpr int LDS_BYTES = 163840;

typedef GAS unsigned gu32;
#define RLX_AGENT __ATOMIC_RELAXED, __HIP_MEMORY_SCOPE_AGENT
#define LDS_WAIT() asm volatile("s_waitcnt lgkmcnt(0)" ::: "memory")

#define XB_TMO      128
#define XB_XCNT(j)  (256  + 64 * (j))
#define XB_XSUB(j)  (1280 + 64 * (j))
#define XB_XGEN(j)  (2304 + 64 * (j))
#define XB_TOP      3328
#define XB_TOPGEN   3392
#define XCD_BAR_WORDS 3456
#define XB_SPIN_CAP (1u << 18)
__device__ __forceinline__ unsigned xb_ld(unsigned* p)              { return __hip_atomic_load(p, __ATOMIC_RELAXED, __HIP_MEMORY_SCOPE_AGENT); }
__device__ __forceinline__ unsigned xb_add(unsigned* p, unsigned v) { return __hip_atomic_fetch_add(p, v, __ATOMIC_RELAXED, __HIP_MEMORY_SCOPE_AGENT); }
__device__ __forceinline__ unsigned xb_xcc_id() { return (unsigned)__builtin_amdgcn_s_getreg((3 << 11) | 20) & 0xFu; }
#define XB_SPIN(cond, bar) do { unsigned _sp = 0; while (cond) { __builtin_amdgcn_s_sleep(1); \
    if ((++_sp & 255u) == 0u) { if (xb_ld(&(bar)[XB_TMO])) break; if (_sp > XB_SPIN_CAP) { atomicAdd(&(bar)[XB_TMO], 1u); break; } } } } while (0)
struct XcdBarrier { unsigned* bar; unsigned x; volatile LAS unsigned* st; };
__device__ __forceinline__ XcdBarrier xcd_barrier_post(unsigned* bar, volatile LAS unsigned* st) {
    XcdBarrier b; b.bar = bar; b.x = xb_xcc_id(); b.st = st;
    if (threadIdx.x == 0) (void)xb_add(&bar[XB_XCNT(b.x)], 1u);
    return b;
}
__device__ __forceinline__ void xcd_barrier_complete(unsigned* bar, unsigned x, unsigned& nloc, unsigned& nx) {
    const unsigned G = gridDim.x * gridDim.y * gridDim.z;
    unsigned sum, cnt, mine, sp = 0u;
    for (;;) {
        sum = 0u; cnt = 0u; mine = 0u;
#pragma unroll
        for (unsigned j = 0; j < 16; ++j) { const unsigned c = xb_ld(&bar[XB_XCNT(j)]); sum += c; cnt += (c > 0u) ? 1u : 0u; mine = (j == x) ? c : mine; }
        if (sum == G) break;
        __builtin_amdgcn_s_sleep(1);
        if ((++sp & 255u) == 0u) { if (xb_ld(&bar[XB_TMO])) break; if (sp > XB_SPIN_CAP) { atomicAdd(&bar[XB_TMO], 1u); break; } }
    }
    nloc = mine > 0u ? mine : 1u; nx = cnt > 0u ? cnt : 1u;
}
template <class F>
__device__ __forceinline__ void xcd_barrier_pf(const XcdBarrier& b, F&& between) {
    asm volatile("s_waitcnt vmcnt(0)" ::: "memory");
    __syncthreads();
    unsigned target = 0u;
    if (threadIdx.x == 0) {
        unsigned* bar = b.bar;
        __builtin_amdgcn_s_waitcnt(0);
        unsigned nloc = b.st[0], nx = b.st[1];
        if (nloc == 0u) { xcd_barrier_complete(bar, b.x, nloc, nx); b.st[0] = nloc; b.st[1] = nx; }
        asm volatile("buffer_inv sc1" ::: "memory");
        const unsigned old = xb_add(&bar[XB_XSUB(b.x)], 1u);
        const unsigned gen = old / nloc;
        if (old - gen * nloc == (nloc >> 1)) asm volatile("buffer_wbl2 sc1" ::: "memory");
        if (old + 1u == (gen + 1u) * nloc) {
            __builtin_amdgcn_fence(__ATOMIC_RELEASE, "agent");
            asm volatile("s_waitcnt vmcnt(0)" ::: "memory");
            (void)xb_add(&bar[XB_TOP], 1u);
        }
        target = (gen + 1u) * nx;
    }
    between();
    if (threadIdx.x == 0) {
        unsigned* bar = b.bar;
        XB_SPIN(xb_ld(&bar[XB_TOP]) < target, bar);
        asm volatile("s_waitcnt vmcnt(0)" ::: "memory");
    }
    __syncthreads();
}
__device__ __forceinline__ void xcd_barrier(const XcdBarrier& b) { xcd_barrier_pf(b, [] {}); }

struct Args { const float* in[18]; float* out; unsigned char* ws; };

__device__ __forceinline__ void transpose_item(const float* W, int ldw, int k0, int n0, bf16_t* WT, int ldt, int wt_row0, const float* kgain, const float* nscale, LAS float* scr, int lane) {
    const int c4 = (lane & 7) * 4, kr = lane >> 3;
    f32x4 v[8];
#pragma unroll
    for (int i = 0; i < 8; ++i) v[i] = *(const f32x4*)(W + (size_t)(k0 + kr + 8 * i) * ldw + n0 + c4);
    f32x4 ns = {1.f, 1.f, 1.f, 1.f};
    if (nscale) ns = *(const f32x4*)(nscale + n0 + c4);
#pragma unroll
    for (int i = 0; i < 8; ++i) { const int kk = kr + 8 * i; f32x4 t = v[i] * ns; if (kgain) t = t * kgain[k0 + kk];
        LAS float* d = scr + kk * 33 + c4; d[0] = t[0]; d[1] = t[1]; d[2] = t[2]; d[3] = t[3]; }
    LDS_WAIT(); asm volatile("" ::: "memory");
    const int c = lane & 7;
#pragma unroll
    for (int j = 0; j < 4; ++j) { const int n = (lane >> 3) + 8 * j; const LAS float* sp = scr + (8 * c) * 33 + n;
        u32x4 o; o[0] = cvtpk(sp[0 * 33], sp[1 * 33]); o[1] = cvtpk(sp[2 * 33], sp[3 * 33]); o[2] = cvtpk(sp[4 * 33], sp[5 * 33]); o[3] = cvtpk(sp[6 * 33], sp[7 * 33]);
        *(u32x4*)(WT + (size_t)(wt_row0 + n0 + n) * ldt + k0 + 8 * c) = o; }
    LDS_WAIT(); asm volatile("" ::: "memory");
}

__global__ void __launch_bounds__(NWAVES * 64, 2) fwd_megakernel(Args args) {
    extern __shared__ __attribute__((aligned(16))) unsigned char lds_raw[];
    LAS unsigned char* lds = (LAS unsigned char*)lds_raw;
    volatile LAS unsigned* MISC = (volatile LAS unsigned*)(lds + MISC_OFF);
    const int tid = threadIdx.x, lane = tid & 63, wave = __builtin_amdgcn_readfirstlane(tid >> 6);
    const int G = gridDim.x; const int bx = blockIdx.x; const int vcu = (G % 8 == 0) ? (bx % 8) * (G / 8) + bx / 8 : bx;
    gu32* ctl = (gu32*)(args.ws + WS_CTL);
#define x          (args.in[0])
#define meta       (args.in[1])
#define rel_bias   (args.in[2])
#define mix_g      (args.in[3])
#define ffn_g      (args.in[4])
#define pool_w     (args.in[5])
#define pool_scale (args.in[6])
#define w_qkv      (args.in[7])
#define w_o        (args.in[8])
#define lq1        (args.in[9])
#define lk1        (args.in[10])
#define lq2        (args.in[11])
#define lk2        (args.in[12])
#define subg       (args.in[13])
#define w_gate     (args.in[14])
#define w_up       (args.in[15])
#define w_down     (args.in[16])
#define fin_g      (args.in[17])
#define Wpool ((bf16_t*)(args.ws + WS_WPOOL))
#define Wgu0  ((bf16_t*)(args.ws + WS_WGU0))
#define Wd0   ((bf16_t*)(args.ws + WS_WD0))
#define Wqkv  ((bf16_t*)(args.ws + WS_WQKV))
#define Wo    ((bf16_t*)(args.ws + WS_WO))
#define Wgu1  ((bf16_t*)(args.ws + WS_WGU1))
#define Wd1   ((bf16_t*)(args.ws + WS_WD1))
#define SSQ   ((float*)(args.ws + WS_SSQ))
#define H     ((float*)(args.ws + WS_H))
#define HB    ((bf16_t*)(args.ws + WS_HB))
#define ACT   ((bf16_t*)(args.ws + WS_ACT))
#define QB_   ((bf16_t*)(args.ws + WS_ACT))
#define KB_   (QB_ + QKV_STRIDE)
#define VB_   (KB_ + QKV_STRIDE)
#define OB_   ((bf16_t*)(args.ws + WS_O))
    for (int u = tid; u < (LDS_BYTES - LDSCTL_OFF) / 4; u += NWAVES * 64) ((LAS unsigned*)(lds + LDSCTL_OFF))[u] = 0u;
    __syncthreads();
    XcdBarrier bar = xcd_barrier_post((unsigned*)(ctl + CW_BAR), MISC + 8);
    const int gw = vcu * NWAVES + wave, NGW = G * NWAVES;

    constexpr int I_POOL = 128, I_GU = 1408, I_DN = 1408, I_QKV = 1536, I_WO = 512;
#define CONVERT_ITEM(it_, scr_) do { int r = (it_); \
        if (r < I_POOL) { const int g = r >> 5, q = r & 31, kb = q >> 3, nb = q & 7; \
            transpose_item(pool_w + (size_t)g * 65536, 256, 64 * kb, 32 * nb, Wpool, 256, g * 256, nullptr, pool_scale + g * 256, scr_, lane); break; } \
        r -= I_POOL; \
        if (r < 4 * I_GU) { const int which = r / I_GU, q = r % I_GU, layer = which >> 1, isup = which & 1, kb = q / 88, nb = q % 88, n0 = 32 * nb; \
            const float* W = (isup ? w_up : w_gate) + (size_t)layer * D * FF; \
            transpose_item(W, FF, 64 * kb, n0, layer ? Wgu1 : Wgu0, D, 256 * (n0 >> 7) + 128 * isup + (n0 & 127) - n0, ffn_g + layer * D, nullptr, scr_, lane); break; } \
        r -= 4 * I_GU; \
        if (r < 2 * I_DN) { const int layer = r / I_DN, q = r % I_DN, kb = q >> 5, nb = q & 31; \
            transpose_item(w_down + (size_t)layer * FF * D, D, 64 * kb, 32 * nb, layer ? Wd1 : Wd0, FF, 0, nullptr, nullptr, scr_, lane); break; } \
        r -= 2 * I_DN; \
        if (r < I_QKV) { const int kb = r / 96, nb = r % 96; \
            transpose_item(w_qkv, 3 * D, 64 * kb, 32 * nb, Wqkv, D, 0, mix_g + D, nullptr, scr_, lane); break; } \
        r -= I_QKV; \
        { const int kb = r >> 5, nb = r & 31; transpose_item(w_o, D, 64 * kb, 32 * nb, Wo, D, 0, nullptr, nullptr, scr_, lane); } } while (0)
    if (PHASE_MASK & (1 << 0))
    {
        LAS float* scr = (LAS float*)(lds + RING_OFF + wave * 16384);
        constexpr int N_EARLY = I_POOL + 2 * I_GU + I_DN + I_QKV;
        for (int e = gw; e < N_EARLY; e += NGW) {
            const int it = e < I_POOL + 2 * I_GU ? e : (e < I_POOL + 2 * I_GU + I_DN ? e + 2 * I_GU : e + 2 * I_GU + I_DN);
            CONVERT_ITEM(it, scr);
        }
        __syncthreads();
        LAS float* hn = (LAS float*)(lds + RING_OFF);
        f32x4 gv[4];
#pragma unroll
        for (int j = 0; j < 4; ++j) gv[j] = *((const f32x4*)mix_g + lane + 64 * j);
        const int pg = tid >> 7, pw_ = 2 << pg;
        const LAS f32x2* pcol = (const LAS f32x2*)hn + tid;
#define POOL_SRC(b_, p_) (((p_) < NMETA) ? meta + (size_t)(p_) * D : x + ((size_t)(b_) * SEQ + ((p_) - NMETA)) * D)
#define POOL_LOAD(dst, src0, src1) do { const f32x4* a_ = (const f32x4*)(src0) + lane; const f32x4* b_ = (const f32x4*)(src1) + lane; \
            _Pragma("unroll") for (int j = 0; j < 4; ++j) { dst[j] = a_[64 * j]; dst[4 + j] = b_[64 * j]; } } while (0)
#define POOL_NORM_STORE(src, half) do { float s0_ = 0.f, s1_ = 0.f; \
            _Pragma("unroll") for (int j = 0; j < 4; ++j) { s0_ += (src[j][0] * src[j][0] + src[j][1] * src[j][1]) + (src[j][2] * src[j][2] + src[j][3] * src[j][3]); \
                                                            s1_ += (src[4 + j][0] * src[4 + j][0] + src[4 + j][1] * src[4 + j][1]) + (src[4 + j][2] * src[4 + j][2] + src[4 + j][3] * src[4 + j][3]); } \
            const float r0_ = __builtin_amdgcn_rsqf(wave_sum(s0_) * (1.0f / D) + RMS_EPS), r1_ = __builtin_amdgcn_rsqf(wave_sum(s1_) * (1.0f / D) + RMS_EPS); \
            LAS f32x4* d0_ = (LAS f32x4*)(hn + ((half) * 16 + 2 * wave) * 1024) + lane; \
            _Pragma("unroll") for (int j = 0; j < 4; ++j) { d0_[64 * j] = src[j] * r0_ * gv[j]; d0_[256 + 64 * j] = src[4 + j] * r1_ * gv[j]; } } while (0)
        for (int run = vcu; run < MMAIN / 128; run += G) {
            const int b = run >> 5, t0 = (run & 31) * 128;
            f32x4 RA[8], RB[8], RC[8];
            { const int p0_ = NMETA + t0 - 16 + 2 * wave; POOL_LOAD(RA, POOL_SRC(b, p0_), POOL_SRC(b, p0_ + 1)); }
            { const int p0_ = NMETA + t0 + 2 * wave; POOL_LOAD(RB, POOL_SRC(b, p0_), POOL_SRC(b, p0_ + 1)); }
            { const int p0_ = NMETA + t0 + 16 + 2 * wave; POOL_LOAD(RC, POOL_SRC(b, p0_), POOL_SRC(b, p0_ + 1)); }
            POOL_NORM_STORE(RA, 1);
#define POOL_STEP(st, Rcur, Rfree) do { const int half = (st) & 1; \
                POOL_NORM_STORE(Rcur, half); \
                if ((st) + 2 < 8) { const int p0_ = NMETA + t0 + 16 * ((st) + 2) + 2 * wave; POOL_LOAD(Rfree, POOL_SRC(b, p0_), POOL_SRC(b, p0_ + 1)); } \
                __syncthreads(); \
                { const int rb = 16 * half; f32x2 sm = {0.f, 0.f}; \
                  for (int i = 1; i < pw_; ++i) sm += pcol[((rb - i) & 31) * 512]; \
                  const float invw = 1.0f / (float)pw_; const size_t orow0 = (size_t)b * SEQ + t0 + 16 * (st); \
                  _Pragma("unroll") for (int o = 0; o < 16; ++o) { const f32x2 cur = pcol[(rb + o) * 512]; sm += cur; const f32x2 pv = sm * invw - cur; \
                      *(unsigned*)(HB + (orow0 + o) * D + 2 * tid) = cvtpk(pv[0], pv[1]); sm -= pcol[((rb + o - pw_ + 1) & 31) * 512]; } } \
                __syncthreads(); } while (0)
            POOL_STEP(0, RB, RA); POOL_STEP(1, RC, RB); POOL_STEP(2, RA, RC); POOL_STEP(3, RB, RA);
            POOL_STEP(4, RC, RB); POOL_STEP(5, RA, RC); POOL_STEP(6, RB, RA); POOL_STEP(7, RC, RB);
#undef POOL_STEP
        }
        if (vcu == 0) {
            f32x4 R[8];
            POOL_LOAD(R, meta + (size_t)(2 * wave) * D, meta + (size_t)(2 * wave + 1) * D);
            POOL_NORM_STORE(R, 0);
            { LAS f32x4* z = (LAS f32x4*)(hn + (16 + 2 * wave) * 1024) + lane;
#pragma unroll
              for (int j = 0; j < 8; ++j) z[64 * j] = (f32x4){0.f, 0.f, 0.f, 0.f}; }
            __syncthreads();
            f32x2 sm = {0.f, 0.f};
#pragma unroll
            for (int o = 0; o < 16; ++o) {
                const f32x2 cur = pcol[o * 512];
                sm += cur;
                const float ic = 1.0f / (float)((o + 1) < pw_ ? (o + 1) : pw_);
                const f32x2 pv = sm * ic - cur;
                *(unsigned*)(HB + ((size_t)META0 + o) * D + 2 * tid) = cvtpk(pv[0], pv[1]);
                sm -= pcol[((o - pw_ + 1) & 31) * 512];
            }
            __syncthreads();
        }
#undef POOL_SRC
#undef POOL_LOAD
#undef POOL_NORM_STORE
        for (int r = META0 + NMETA + gw; r < MPAD; r += NGW) { u32x4* p = (u32x4*)(HB + (size_t)r * D) + lane * 2; p[0] = (u32x4){0u, 0u, 0u, 0u}; p[1] = (u32x4){0u, 0u, 0u, 0u}; }
    }
    xcd_barrier(bar);

    if (PHASE_MASK & (1 << 1))
    {
        pg8::Gemm g{HB, Wpool, MPAD, D, 256, D, 256, MMAIN / 256}; pg8::StaticOrder S; S.init(MMAIN, D, G, bx);
        pg8::EpiRes E{x, MMAIN, meta, NMETA, nullptr, HB, SSQ};
        pg8::gemm_phase<pg8::EpiRes, pg8::StaticOrder, true>(lds + RING_OFF, g, S, E);
        pg8::MetaOrder SM{MMAIN / 256, D / 256, bx};
        pg8::gemm_phase<pg8::EpiRes, pg8::MetaOrder, true, true>(lds + RING_OFF, g, SM, E);
    }
    { pg8::Gemm gn_{HB, Wgu0, MPAD, 2 * FF, D, D, 0, MMAIN / 256}; pg8::StaticOrder Sn_; Sn_.init(MMAIN, 2 * FF, G, bx);
      xcd_barrier_pf(bar, [&] { pg8::prefetch_b<pg8::EpiSwiGLU, pg8::StaticOrder>(lds + RING_OFF, gn_, Sn_); }); }
    if (PHASE_MASK & (1 << 2))
    {
        pg8::Gemm g{HB, Wgu0, MPAD, 2 * FF, D, D, 0, MMAIN / 256}; pg8::StaticOrder S; S.init(MMAIN, 2 * FF, G, bx);
        pg8::EpiSwiGLU E{ACT, SSQ, (LAS const unsigned char*)(lds + RING_OFF + pg8::SSQ_LDS)};
        for (int rep = 0; rep < REP_GU; ++rep)
        pg8::gemm_phase<pg8::EpiSwiGLU, pg8::StaticOrder, true, false, true>(lds + RING_OFF, g, S, E);
        if (bx < FF / 16) {
            const int f0 = bx * 16; const int nrow[2] = {256 * (f0 >> 7) + (f0 & 127), 256 * (f0 >> 7) + 128 + (f0 & 127)};
            f32x4 macc[2];
            if (mrow::partial_reduce<2, D / 256>(HB + (size_t)META0 * D, D, Wgu0, D, nrow, wave, lane, (LAS f32x4*)(lds + RING_OFF), macc)) {
                const int row = META0 + (lane & 15); const float rs = pg8::row_rstd(SSQ, row);
                float o[4];
#pragma unroll
                for (int e = 0; e < 4; ++e) { const float gt = macc[0][e] * rs, up = macc[1][e] * rs; o[e] = gt * __builtin_amdgcn_rcpf(1.0f + __builtin_amdgcn_exp2f(-gt * LOG2E)) * up; }
                *(u32x2*)(ACT + (size_t)row * FF + f0 + 4 * (lane >> 4)) = (u32x2){cvtpk(o[0], o[1]), cvtpk(o[2], o[3])};
            }
            __syncthreads();
        }
    }
    { pg8::Gemm gn_{ACT, Wd0, MPAD, D, FF, FF, 0, MMAIN / 256}; pg8::StaticOrder Sn_; Sn_.init(MMAIN, D, G, bx);
      xcd_barrier_pf(bar, [&] { pg8::prefetch_b<pg8::EpiRes, pg8::StaticOrder>(lds + RING_OFF, gn_, Sn_); }); }
    if (PHASE_MASK & (1 << 3))
    {
        pg8::Gemm g{ACT, Wd0, MPAD, D, FF, FF, 0, MMAIN / 256}; pg8::StaticOrder S; S.init(MMAIN, D, G, bx);
        pg8::EpiRes E{nullptr, 0, nullptr, 0, HB, HB, SSQ};
        pg8::gemm_phase<pg8::EpiRes, pg8::StaticOrder, true, false, true>(lds + RING_OFF, g, S, E);
        if (bx < 16) {
            const int nrow[4] = {bx * 64, bx * 64 + 16, bx * 64 + 32, bx * 64 + 48};
            f32x4 macc[4];
            if (mrow::partial_reduce<4, FF / 256>(ACT + (size_t)META0 * FF, FF, Wd0, FF, nrow, wave, lane, (LAS f32x4*)(lds + RING_OFF), macc)) {
                const int row = META0 + (lane & 15); float ss = 0.f;
#pragma unroll
                for (int nb = 0; nb < 4; ++nb) { bf16_t* hp = HB + (size_t)row * D + nrow[nb] + 4 * (lane >> 4); const u32x2 rb = *(const u32x2*)hp;
                    const float v0 = macc[nb][0] + __uint_as_float(rb[0] << 16), v1 = macc[nb][1] + __uint_as_float(rb[0] & 0xffff0000u), v2 = macc[nb][2] + __uint_as_float(rb[1] << 16), v3 = macc[nb][3] + __uint_as_float(rb[1] & 0xffff0000u);
                    *(u32x2*)hp = (u32x2){cvtpk(v0, v1), cvtpk(v2, v3)}; ss += (v0 * v0 + v1 * v1) + (v2 * v2 + v3 * v3); }
                ss += __shfl_xor(ss, 16); ss += __shfl_xor(ss, 32);
                if (lane < 16) SSQ[(size_t)row * 16 + bx] = ss;
            }
            __syncthreads();
        }
        if (bx >= 16) {
            LAS float* scr = (LAS float*)(lds + RING_OFF + wave * 16384);
            constexpr int N_LATE = 2 * I_GU + I_DN + I_WO;
            const int lw = (bx - 16) * NWAVES + wave, nlw = (G - 16) * NWAVES;
            for (int l = lw; l < N_LATE; l += nlw) {
                const int it = l < 2 * I_GU ? I_POOL + 2 * I_GU + l : (l < 2 * I_GU + I_DN ? I_POOL + 4 * I_GU + I_DN + (l - 2 * I_GU) : I_POOL + 4 * I_GU + 2 * I_DN + I_QKV + (l - 2 * I_GU - I_DN));
                CONVERT_ITEM(it, scr);
            }
        }
    }
    { pg8::Gemm gn_{HB, Wqkv, MPAD, 3 * D, D, D, 0, MMAIN / 256}; pg8::StaticOrder Sn_; Sn_.init(MMAIN, 3 * D, G, bx);
      xcd_barrier_pf(bar, [&] { pg8::prefetch_b<pg8::EpiQKV, pg8::StaticOrder>(lds + RING_OFF, gn_, Sn_); }); }
    if (PHASE_MASK & (1 << 4))
    {
        pg8::Gemm g{HB, Wqkv, MPAD, 3 * D, D, D, 0, MMAIN / 256}; pg8::StaticOrder S; S.init(MMAIN, 3 * D, G, bx);
        pg8::EpiQKV E{QB_, QKV_STRIDE, SSQ, (unsigned*)(ctl + CW_KMAX), (LAS const unsigned char*)(lds + RING_OFF + pg8::SSQ_LDS)};
        for (int rep = 0; rep < REP_MISC; ++rep)
        pg8::gemm_phase<pg8::EpiQKV, pg8::StaticOrder, true, false, true>(lds + RING_OFF, g, S, E);
        if (bx < 3 * D / 16) {
            const int n0 = bx * 16; const int nrow[1] = {n0};
            f32x4 macc[1];
            if (mrow::partial_reduce<1, D / 256>(HB + (size_t)META0 * D, D, Wqkv, D, nrow, wave, lane, (LAS f32x4*)(lds + RING_OFF), macc)) {
                const int row = META0 + (lane & 15); const int t = n0 >> 10; const float rs = pg8::row_rstd(SSQ, row) * (t == 0 ? QSCALE : 1.0f);
                const f32x4 v = macc[0] * rs;
                *(u32x2*)(QB_ + (size_t)t * QKV_STRIDE + (size_t)row * D + (n0 & 1023) + 4 * (lane >> 4)) = (u32x2){cvtpk(v[0], v[1]), cvtpk(v[2], v[3])};
                if (t == 1) {
                    float mx = __builtin_fmaxf(__builtin_fmaxf(__builtin_fabsf(v[0]), __builtin_fabsf(v[1])), __builtin_fmaxf(__builtin_fabsf(v[2]), __builtin_fabsf(v[3])));
#pragma unroll
                    for (int o = 1; o < 64; o <<= 1) mx = __builtin_fmaxf(mx, __shfl_xor(mx, o));
                    if (lane == 0) atomicMax((unsigned*)(ctl + CW_KMAX) + 128 + ((n0 & 1023) >> 7) * 2 + ((n0 & 127) >> 6), __float_as_uint(mx));
                }
            }
            __syncthreads();
        }
    }
    xcd_barrier(bar);
    if (PHASE_MASK & (1 << 5))
    {
        float a1 = lq1[lane] * lk1[lane], a2 = lq2[lane] * lk2[lane];
        a1 = wave_sum(a1); a2 = wave_sum(a2);
        const float lam = __expf(a1) - __expf(a2) + LAMBDA_INIT;
        for (int rep = 0; rep < REP_P5; ++rep)
        for (int idx = vcu; idx < 2048; idx += G) {
            const int vv = idx & 255, i = idx >> 8, xg = vv >> 5, j = vv & 31, bh = xg * 8 + i, qb = (i & 1) ? 31 - j : j;
            att::attn_unit(bh >> 3, bh & 7, qb, QB_, KB_, VB_, OB_, lds + RING_OFF, rel_bias, subg, lam, (unsigned*)(ctl + CW_KMAX));
        }
    }
    { pg8::Gemm gn_{OB_, Wo, MMAIN, D, D, D, 0, MMAIN / 256}; pg8::StaticOrder Sn_; Sn_.init(MMAIN, D, G, bx);
      xcd_barrier_pf(bar, [&] { pg8::prefetch_b<pg8::EpiRes, pg8::StaticOrder>(lds + RING_OFF, gn_, Sn_); }); }
    if (PHASE_MASK & (1 << 6))
    {
        pg8::Gemm g{OB_, Wo, MMAIN, D, D, D, 0, MMAIN / 256}; pg8::StaticOrder S; S.init(MMAIN, D, G, bx);
        pg8::EpiRes E{nullptr, 0, nullptr, 0, HB, HB, SSQ};
        pg8::gemm_phase<pg8::EpiRes, pg8::StaticOrder, true, false, true>(lds + RING_OFF, g, S, E);
    }
    { pg8::Gemm gn_{HB, Wgu1, MMAIN, 2 * FF, D, D, 0, MMAIN / 256}; pg8::StaticOrder Sn_; Sn_.init(MMAIN, 2 * FF, G, bx);
      xcd_barrier_pf(bar, [&] { pg8::prefetch_b<pg8::EpiSwiGLU, pg8::StaticOrder>(lds + RING_OFF, gn_, Sn_); }); }
    if (PHASE_MASK & (1 << 7))
    {
        pg8::Gemm g{HB, Wgu1, MMAIN, 2 * FF, D, D, 0, MMAIN / 256}; pg8::StaticOrder S; S.init(MMAIN, 2 * FF, G, bx);
        pg8::EpiSwiGLU E{ACT, SSQ, (LAS const unsigned char*)(lds + RING_OFF + pg8::SSQ_LDS)};
        for (int rep = 0; rep < REP_GU; ++rep)
        pg8::gemm_phase<pg8::EpiSwiGLU, pg8::StaticOrder, true, false, true>(lds + RING_OFF, g, S, E);
    }
    { pg8::Gemm gn_{ACT, Wd1, MMAIN, D, FF, FF, 0, MMAIN / 256}; pg8::StaticOrder Sn_; Sn_.init(MMAIN, D, G, bx);
      xcd_barrier_pf(bar, [&] { pg8::prefetch_b<pg8::EpiRes, pg8::StaticOrder>(lds + RING_OFF, gn_, Sn_); }); }
    if (PHASE_MASK & (1 << 8))
    {
        pg8::Gemm g{ACT, Wd1, MMAIN, D, FF, FF, 0, MMAIN / 256}; pg8::StaticOrder S; S.init(MMAIN, D, G, bx);
        pg8::EpiRes E{nullptr, 0, nullptr, 0, HB, HB, SSQ};
        pg8::gemm_phase<pg8::EpiRes, pg8::StaticOrder, true, false, true>(lds + RING_OFF, g, S, E);
    }
    xcd_barrier(bar);
    if (PHASE_MASK & (1 << 9))
    {
        int lane9_ = (int)__builtin_amdgcn_mbcnt_hi(~0u, __builtin_amdgcn_mbcnt_lo(~0u, 0u)); asm volatile("" : "+v"(lane9_));
        const int lane = lane9_;
        f32x4 gv[4];
#pragma unroll
        for (int j = 0; j < 4; ++j) gv[j] = *((const f32x4*)fin_g + lane + 64 * j);
        const unsigned poison = xb_ld((unsigned*)(ctl + CW_BAR) + XB_TMO);
#define P9_LOAD(W, Q, r_) do { const int rr_ = (r_) < MMAIN ? (r_) : MMAIN - 1;     \
            const u32x2* hp_ = (const u32x2*)(HB + (size_t)rr_ * D) + lane; const f32x4* qp_ = (const f32x4*)(SSQ + (size_t)rr_ * 16); \
            _Pragma("unroll") for (int j = 0; j < 4; ++j) { W[j] = hp_[64 * j]; Q[j] = qp_[j]; } } while (0)
#define P9_FINISH(W, Q, r_) do { { \
            const float sq_ = ((Q[0][0] + Q[0][1]) + (Q[0][2] + Q[0][3])) + ((Q[1][0] + Q[1][1]) + (Q[1][2] + Q[1][3])) + ((Q[2][0] + Q[2][1]) + (Q[2][2] + Q[2][3])) + ((Q[3][0] + Q[3][1]) + (Q[3][2] + Q[3][3])); \
            float rs_ = __builtin_amdgcn_rsqf(sq_ * (1.0f / D) + RMS_EPS); if (poison) rs_ = __builtin_nanf(""); \
            f32x4* o_ = (f32x4*)(args.out + (size_t)(r_) * D) + lane; \
            _Pragma("unroll") for (int j = 0; j < 4; ++j) { const f32x4 v_ = {__uint_as_float(W[j][0] << 16), __uint_as_float(W[j][0] & 0xffff0000u), __uint_as_float(W[j][1] << 16), __uint_as_float(W[j][1] & 0xffff0000u)}; \
                o_[64 * j] = v_ * rs_ * gv[j]; } } } while (0)
        u32x2 wa[4], wb[4]; f32x4 qa[4], qb4[4];
#pragma unroll
        for (int j = 0; j < 4; ++j) { wa[j] = (u32x2){0u, 0u}; wb[j] = (u32x2){0u, 0u}; qa[j] = (f32x4){0.f, 0.f, 0.f, 0.f}; qb4[j] = (f32x4){0.f, 0.f, 0.f, 0.f}; }
        if (MMAIN % (2 * NGW) == 0) {
            P9_LOAD(wa, qa, gw);
            for (int r = gw; r < MMAIN; r += 2 * NGW) {
                P9_LOAD(wb, qb4, r + NGW);
                P9_FINISH(wa, qa, r);
                P9_LOAD(wa, qa, r + 2 * NGW);
                P9_FINISH(wb, qb4, r + NGW);
            }
        } else {
            for (int r = gw; r < MMAIN; r += NGW) { P9_LOAD(wa, qa, r); P9_FINISH(wa, qa, r); }
        }
#undef P9_LOAD
#undef P9_FINISH
    }
}

#undef CONVERT_ITEM
#undef x
#undef meta
#undef rel_bias
#undef mix_g
#undef ffn_g
#undef pool_w
#undef pool_scale
#undef w_qkv
#undef w_o
#undef lq1
#undef lk1
#undef lq2
#undef lk2
#undef subg
#undef w_gate
#undef w_up
#undef w_down
#undef fin_g
#undef Wpool
#undef Wgu0
#undef Wd0
#undef Wqkv
#undef Wo
#undef Wgu1
#undef Wd1
#undef SSQ
#undef H
#undef HB
#undef ACT
#undef QB_
#undef KB_
#undef VB_
#undef OB_

extern "C" void kernel_launch(void* const* d_in, const int* in_sizes, int n_in, void* d_out, int out_size, void* d_ws, size_t ws_size, hipStream_t stream) {
    static int grid = 0;
    if (grid == 0) {
        if (n_in != 18 || in_sizes[0] != MMAIN * D || out_size != MMAIN * D || ws_size < WS_END) {
            fprintf(stderr, "kernel_launch: unexpected shapes (n_in %d, in0 %d, out %d, ws %zu); nothing launched\n", n_in, n_in > 0 ? in_sizes[0] : -1, out_size, ws_size); grid = -1; return; }
        int dev = 0, cus = 0, per_cu = 0;
        if (hipGetDevice(&dev) != hipSuccess || hipDeviceGetAttribute(&cus, hipDeviceAttributeMultiprocessorCount, dev) != hipSuccess) { fprintf(stderr, "kernel_launch: device query failed\n"); grid = -1; return; }
        if (hipFuncSetAttribute((const void*)fwd_megakernel, hipFuncAttributeMaxDynamicSharedMemorySize, LDS_BYTES) != hipSuccess) { fprintf(stderr, "kernel_launch: hipFuncSetAttribute failed\n"); grid = -1; return; }
        if (hipOccupancyMaxActiveBlocksPerMultiprocessor(&per_cu, (const void*)fwd_megakernel, NWAVES * 64, LDS_BYTES) != hipSuccess || per_cu < 1) {
            fprintf(stderr, "kernel_launch: occupancy query reports %d workgroups per CU; nothing launched\n", per_cu); (void)hipGetLastError(); grid = -1; return; }
        grid = cus;
    }
    if (grid < 0) return;
    if (hipMemsetAsync((char*)d_ws + WS_CTL, 0, CTL_ZERO_BYTES, stream) != hipSuccess) { fprintf(stderr, "kernel_launch: hipMemsetAsync failed\n"); return; }
    Args a{};
    for (int i = 0; i < 18; ++i) a.in[i] = (const float*)d_in[i];
    a.out = (float*)d_out; a.ws = (unsigned char*)d_ws;
    hipLaunchKernelGGL(fwd_megakernel, dim3(grid), dim3(NWAVES * 64), LDS_BYTES, stream, a);
    const hipError_t le = hipPeekAtLastError();
    if (le != hipSuccess) fprintf(stderr, "kernel_launch: launch failed: %s\n", hipGetErrorName(le));
}
```

```cpp
#include <hip/hip_runtime.h>
#include <cstdio>
#include <cstdint>

#define LAS __attribute__((address_space(3)))
#define GAS __attribute__((address_space(1)))

typedef unsigned short bf16_t;
typedef short bf16x8 __attribute__((ext_vector_type(8)));
typedef short s16x4 __attribute__((ext_vector_type(4)));
typedef float f32x4 __attribute__((ext_vector_type(4)));
typedef float f32x2 __attribute__((ext_vector_type(2)));
typedef float f32x16 __attribute__((ext_vector_type(16)));
typedef unsigned u32x4 __attribute__((ext_vector_type(4)));
typedef unsigned u32x2 __attribute__((ext_vector_type(2)));
typedef __bf16 bf16x2_t __attribute__((ext_vector_type(2)));

constexpr int D = 1024, NB = 8, SEQ = 4096, NMETA = 16, FF = 2816, NH = 8;
constexpr int MMAIN = NB * SEQ;
constexpr int META0 = MMAIN;
constexpr int MPAD = MMAIN + 256;
constexpr float RMS_EPS = 1e-6f;
constexpr float LOG2E = 1.4426950408889634f;
constexpr float QSCALE = 0.125f * LOG2E;
constexpr float LAMBDA_INIT = 0.35550906759096926f;

__device__ __forceinline__ unsigned cvtpk(float lo, float hi) { f32x2 v = {lo, hi}; bf16x2_t b = __builtin_convertvector(v, bf16x2_t); return __builtin_bit_cast(unsigned, b); }
__device__ __forceinline__ float wave_sum(float v) {
#pragma unroll
    for (int o = 1; o < 64; o <<= 1) v += __shfl_xor(v, o);
    return v;
}

namespace pg8 {
constexpr int SSQ_LDS = 131072 + 8192;
constexpr int BM = 256, BK = 64, HALF = 128, HTB = HALF * BK * 2, STAGE_BYTES = 8 * HTB, NXCD = 8, WGM = 4;
__host__ __device__ __forceinline__ int lds_byte(int r, int c) { const int st = (r >> 4) * 2 + (c >> 5), rr = r & 15, cc = c & 31, ob = rr * 64 + cc * 2; return st * 1024 + (ob ^ (((ob >> 9) & 1) << 5)); }
__host__ __device__ __forceinline__ void stage_rc(int b, int& R, int& C) { const int st = b / 1024, sb = b % 1024, swz = sb ^ (((sb >> 9) & 1) << 5); R = (st >> 1) * 16 + swz / 64; C = (st & 1) * 32 + (swz % 64) / 2; }
__host__ __device__ __forceinline__ int perm32(int rho) { const int n = rho >> 4, i = rho & 15; return 8 * (i >> 2) + 4 * n + (i & 3); }

struct Unit { int pm, pn; };
struct Gemm { const bf16_t* A; const bf16_t* Bt; int M, N, K; int lda; int a_pn_off; int m_full; };

struct StaticOrder {
    int nM, nN, nwg, G, c;
    __device__ void init(int M, int N, int G_, int c_) { nM = M / BM; nN = N / BM; nwg = nM * nN; G = G_; c = c_; }
    __device__ bool next(int i, Unit& u) const {
        const long L = (long)i * G + c; if (L >= nwg) return false;
        int wgid = (int)L; { const int q = nwg / NXCD, r = nwg % NXCD, xcd = wgid % NXCD, off = wgid / NXCD; wgid = (xcd < r ? xcd * (q + 1) : r * (q + 1) + (xcd - r) * q) + off; }
        const int nig = WGM * nN, gid = wgid / nig, fm = gid * WGM, gsz = (nM - fm) < WGM ? (nM - fm) : WGM;
        u.pm = fm + ((wgid % nig) % gsz); u.pn = (wgid % nig) / gsz; return true;
    }
};

struct MetaOrder {
    int pm, nN, c;
    __device__ bool next(int i, Unit& u) const { if (i > 0 || c >= nN) return false; u.pm = pm; u.pn = c; return true; }
};

__device__ __forceinline__ float row_rstd(const float* ssq, int row) {
    const f32x4* p = (const f32x4*)(ssq + (size_t)row * 16);
    const f32x4 a = p[0], b = p[1], c = p[2], d = p[3];
    const float s = ((a[0] + a[1]) + (a[2] + a[3])) + ((b[0] + b[1]) + (b[2] + b[3])) + ((c[0] + c[1]) + (c[2] + c[3])) + ((d[0] + d[1]) + (d[2] + d[3]));
    return __builtin_amdgcn_rsqf(s * (1.0f / D) + RMS_EPS);
}

__device__ __forceinline__ float row_rstd_lds(LAS const unsigned char* blk, int r) {
    const LAS f32x4* p = (const LAS f32x4*)(blk + r * 64);
    const f32x4 a = p[0], b = p[1], c = p[2], d = p[3];
    const float s = ((a[0] + a[1]) + (a[2] + a[3])) + ((b[0] + b[1]) + (b[2] + b[3])) + ((c[0] + c[1]) + (c[2] + c[3])) + ((d[0] + d[1]) + (d[2] + d[3]));
    return __builtin_amdgcn_rsqf(s * (1.0f / D) + RMS_EPS);
}

struct EpiRes {
    static constexpr bool PERM = true; static constexpr bool RSTD_LDS = false; static constexpr int NSTORES = 16;
    const float* r_main; int n_main; const float* r_aux; int n_aux;
    const bf16_t* r_bf;
    bf16_t* Hb; float* ssq;
    __device__ __forceinline__ void finish(const f32x4 (&acc)[2][2][4][2], int ai, int m, int bj, int row, int col, const f32x4& r0, const f32x4& r1, float& s) const {
        const f32x4 v0 = acc[ai][bj][m][0] + r0, v1 = acc[ai][bj][m][1] + r1;
        u32x4 w; w[0] = cvtpk(v0[0], v0[1]); w[1] = cvtpk(v0[2], v0[3]); w[2] = cvtpk(v1[0], v1[1]); w[3] = cvtpk(v1[2], v1[3]);
        *(u32x4*)(Hb + (size_t)row * D + col) = w;
        s += (v0[0] * v0[0] + v0[1] * v0[1]) + (v0[2] * v0[2] + v0[3] * v0[3]) + (v1[0] * v1[0] + v1[1] * v1[1]) + (v1[2] * v1[2] + v1[3] * v1[3]);
    }
    __device__ __forceinline__ void operator()(const f32x4 (&acc)[2][2][4][2], const Unit& u, int wr, int wc, int fr, int fq) const {
        const int col0 = u.pn * BM + wc * 32 + 8 * fq;
        const int row0 = u.pm * BM + wr * 64 + fr;
        if (r_bf) {
            u32x4 rb[2][4][2];
#pragma unroll
            for (int ai = 0; ai < 2; ++ai)
#pragma unroll
                for (int m = 0; m < 4; ++m)
#pragma unroll
                    for (int bj = 0; bj < 2; ++bj) rb[ai][m][bj] = *(const u32x4*)(r_bf + (size_t)(row0 + ai * HALF + m * 16) * D + col0 + bj * HALF);
#pragma unroll
            for (int ai = 0; ai < 2; ++ai)
#pragma unroll
                for (int m = 0; m < 4; ++m) {
                    const int row = row0 + ai * HALF + m * 16;
                    float s = 0.f;
#pragma unroll
                    for (int bj = 0; bj < 2; ++bj) { const u32x4 q = rb[ai][m][bj];
                        const f32x4 r0 = {__uint_as_float(q[0] << 16), __uint_as_float(q[0] & 0xffff0000u), __uint_as_float(q[1] << 16), __uint_as_float(q[1] & 0xffff0000u)};
                        const f32x4 r1 = {__uint_as_float(q[2] << 16), __uint_as_float(q[2] & 0xffff0000u), __uint_as_float(q[3] << 16), __uint_as_float(q[3] & 0xffff0000u)};
                        finish(acc, ai, m, bj, row, col0 + bj * HALF, r0, r1, s); }
                    s += __shfl_xor(s, 16); s += __shfl_xor(s, 32);
                    if (fq == 0) ssq[(size_t)row * 16 + u.pn * 4 + wc] = s;
                }
        } else {
#pragma unroll
            for (int ai = 0; ai < 2; ++ai) {
                f32x4 rf[4][2][2];
#pragma unroll
                for (int m = 0; m < 4; ++m) {
                    const int row = row0 + ai * HALF + m * 16;
                    const float* rp = row < n_main ? r_main + (size_t)row * D : ((row - n_main) < n_aux ? r_aux + (size_t)(row - n_main) * D : nullptr);
#pragma unroll
                    for (int bj = 0; bj < 2; ++bj) { rf[m][bj][0] = (f32x4){0.f, 0.f, 0.f, 0.f}; rf[m][bj][1] = (f32x4){0.f, 0.f, 0.f, 0.f};
                        if (rp) { rf[m][bj][0] = *(const f32x4*)(rp + col0 + bj * HALF); rf[m][bj][1] = *(const f32x4*)(rp + col0 + bj * HALF + 4); } }
                }
#pragma unroll
                for (int m = 0; m < 4; ++m) {
                    const int row = row0 + ai * HALF + m * 16;
                    float s = 0.f;
#pragma unroll
                    for (int bj = 0; bj < 2; ++bj) finish(acc, ai, m, bj, row, col0 + bj * HALF, rf[m][bj][0], rf[m][bj][1], s);
                    s += __shfl_xor(s, 16); s += __shfl_xor(s, 32);
                    if (fq == 0) ssq[(size_t)row * 16 + u.pn * 4 + wc] = s;
                }
            }
        }
    }
};

struct EpiSwiGLU {
    static constexpr bool PERM = true; static constexpr bool RSTD_LDS = true; static constexpr int NSTORES = 8;
    bf16_t* ACT; const float* ssq; LAS const unsigned char* blk;
    __device__ __forceinline__ void operator()(const f32x4 (&acc)[2][2][4][2], const Unit& u, int wr, int wc, int fr, int fq) const {
        const int col0 = u.pn * HALF + wc * 32 + 8 * fq;
        const int ln = fq * 16 + fr;
        const float rsA = row_rstd_lds(blk, wr * 64 + ln), rsB = row_rstd_lds(blk, HALF + wr * 64 + ln);
#pragma unroll
        for (int ai = 0; ai < 2; ++ai)
#pragma unroll
            for (int m = 0; m < 4; ++m) {
                const int row = u.pm * BM + ai * HALF + wr * 64 + m * 16 + fr;
                const float rs = __shfl(ai ? rsB : rsA, m * 16 + fr);
                float o[8];
#pragma unroll
                for (int n = 0; n < 2; ++n)
#pragma unroll
                    for (int e = 0; e < 4; ++e) {
                        const float g = acc[ai][0][m][n][e] * rs, up = acc[ai][1][m][n][e] * rs;
                        const float sg = __builtin_amdgcn_rcpf(1.0f + __builtin_amdgcn_exp2f(-g * LOG2E));
                        o[n * 4 + e] = g * sg * up;
                    }
                u32x4 w; w.x = cvtpk(o[0], o[1]); w.y = cvtpk(o[2], o[3]); w.z = cvtpk(o[4], o[5]); w.w = cvtpk(o[6], o[7]);
                *(u32x4*)(ACT + (size_t)row * FF + col0) = w;
            }
    }
};

struct EpiQKV {
    static constexpr bool PERM = true; static constexpr bool RSTD_LDS = true; static constexpr int NSTORES = 16;
    bf16_t* Q; size_t tstride; const float* ssq; unsigned* kmax; LAS const unsigned char* blk;
    __device__ __forceinline__ void operator()(const f32x4 (&acc)[2][2][4][2], const Unit& u, int wr, int wc, int fr, int fq) const {
        float kx0 = 0.f, kx1 = 0.f;
        const int t = u.pn >> 2; bf16_t* base = Q + (size_t)t * tstride; const float sc = (t == 0) ? QSCALE : 1.0f;
        const int col0 = (u.pn & 3) * BM + wc * 32 + 8 * fq;
        const int ln = fq * 16 + fr;
        const float rsA = row_rstd_lds(blk, wr * 64 + ln), rsB = row_rstd_lds(blk, HALF + wr * 64 + ln);
#pragma unroll
        for (int ai = 0; ai < 2; ++ai)
#pragma unroll
            for (int m = 0; m < 4; ++m) {
                const int row = u.pm * BM + ai * HALF + wr * 64 + m * 16 + fr;
                const float rs = __shfl(ai ? rsB : rsA, m * 16 + fr) * sc;
#pragma unroll
                for (int bj = 0; bj < 2; ++bj) {
                    const f32x4 v0 = acc[ai][bj][m][0] * rs, v1 = acc[ai][bj][m][1] * rs;
                    u32x4 w; w.x = cvtpk(v0[0], v0[1]); w.y = cvtpk(v0[2], v0[3]); w.z = cvtpk(v1[0], v1[1]); w.w = cvtpk(v1[2], v1[3]);
                    *(u32x4*)(base + (size_t)row * D + col0 + bj * HALF) = w;
                    if (t == 1) { const float mx = __builtin_fmaxf(__builtin_fmaxf(__builtin_fmaxf(__builtin_fabsf(v0[0]), __builtin_fabsf(v0[1])), __builtin_fmaxf(__builtin_fabsf(v0[2]), __builtin_fabsf(v0[3]))),
                                                              __builtin_fmaxf(__builtin_fmaxf(__builtin_fabsf(v1[0]), __builtin_fabsf(v1[1])), __builtin_fmaxf(__builtin_fabsf(v1[2]), __builtin_fabsf(v1[3]))));
                        if (bj == 0) kx0 = __builtin_fmaxf(kx0, mx); else kx1 = __builtin_fmaxf(kx1, mx); }
                }
            }
        if (t == 1) {
#pragma unroll
            for (int o = 1; o < 64; o <<= 1) { kx0 = __builtin_fmaxf(kx0, __shfl_xor(kx0, o)); kx1 = __builtin_fmaxf(kx1, __shfl_xor(kx1, o)); }
            if (fr == 0 && fq == 0) { unsigned* kp = kmax + (((u.pm >> 4) * 8 + (u.pn & 3) * 2) * 2 + (wc >> 1));
                atomicMax(kp, __float_as_uint(kx0)); atomicMax(kp + 2, __float_as_uint(kx1)); }
        }
    }
};

template <class Epi, class Sched, bool ALIGN_EPI, bool SHORT = false, bool BPRE = false>
__device__ __forceinline__ void gemm_phase(LAS unsigned char* lds, const Gemm g, const Sched& S, const Epi& E) {
    int tid_ = threadIdx.x; asm volatile("" : "+v"(tid_));
    const int tid = tid_, wid = __builtin_amdgcn_readfirstlane(tid >> 6), lane = tid & 63, wr = wid >> 2, wc = wid & 3, fr = lane & 15, fq = lane >> 4;
    const int K = g.K, nt = K / BK, lda = g.lda;
    unsigned voffA[2], voffB[2];
#pragma unroll
    for (int i = 0; i < 2; ++i) { int R, C; stage_rc(tid * 16 + i * 8192, R, C); const int Rb = Epi::PERM ? ((R & ~31) + perm32(R & 31)) : R;
        voffA[i] = (unsigned)((SHORT ? (R & 15) : R) * lda + C) * 2u; voffB[i] = (unsigned)(Rb * K + C) * 2u; }
    const size_t kstep = (size_t)(BK * 2);
    const size_t tstepA = (size_t)BM * lda * 2, hstepA = SHORT ? 0 : (size_t)HALF * lda * 2;
    const size_t hstepB = (size_t)HALF * K * 2, tstepB = 2 * hstepB;
    const size_t pnoffA = (size_t)g.a_pn_off * 2;
    const unsigned ldsdst = (unsigned)__builtin_amdgcn_readfirstlane((int)((unsigned)(uintptr_t)lds + (unsigned)wid * 1024u));
    const unsigned ldsssq = (unsigned)__builtin_amdgcn_readfirstlane((int)((unsigned)(uintptr_t)lds + (unsigned)SSQ_LDS + (unsigned)wid * 2048u));
    const int aoff = lds_byte(wr * 64 + fr, fq * 8), boff = lds_byte(wc * 32 + fr, fq * 8);
#define PG8_SA(b, h) (((b) * 2 + (h)) * HTB)
#define PG8_SB(b, h) ((4 + (b) * 2 + (h)) * HTB)
#define PG8_STAGE(bufoff, gbase, voff) do { _Pragma("unroll") for (int _i = 0; _i < 2; ++_i) \
        asm volatile("s_mov_b32 m0, %2\n\ts_nop 0\n\tglobal_load_lds_dwordx4 %0, %1" :: "v"((voff)[_i]), "s"((const char*)(gbase)), "s"(ldsdst + (unsigned)((bufoff) + _i * 8192)) : "memory"); } while (0)
#define PG8_LDA(dst, b, h) do { _Pragma("unroll") for (int m = 0; m < 4; ++m) _Pragma("unroll") for (int k = 0; k < 2; ++k) dst[m][k] = *(const LAS bf16x8*)(lds + PG8_SA(b, h) + aoff + m * 2048 + k * 1024); } while (0)
#define PG8_LDB(dst, b, h) do { _Pragma("unroll") for (int n = 0; n < 2; ++n) _Pragma("unroll") for (int k = 0; k < 2; ++k) dst[n][k] = *(const LAS bf16x8*)(lds + PG8_SB(b, h) + boff + n * 2048 + k * 1024); } while (0)
#define PG8_MMA(ai, bj, At, Bt) do { if constexpr (!SHORT) { __builtin_amdgcn_s_setprio(1); _Pragma("unroll") for (int m = 0; m < 4; ++m) _Pragma("unroll") for (int n = 0; n < 2; ++n) _Pragma("unroll") for (int k = 0; k < 2; ++k) \
        acc[ai][bj][m][n] = __builtin_amdgcn_mfma_f32_16x16x32_bf16(Bt[n][k], At[m][k], acc[ai][bj][m][n], 0, 0, 0); __builtin_amdgcn_s_setprio(0); } \
      else if ((ai) == 0) { if (wr == 0) { _Pragma("unroll") for (int n = 0; n < 2; ++n) _Pragma("unroll") for (int k = 0; k < 2; ++k) \
        acc[0][bj][0][n] = __builtin_amdgcn_mfma_f32_16x16x32_bf16(Bt[n][k], At[0][k], acc[0][bj][0][n], 0, 0, 0); } } } while (0)
#define PG8_WAIT_V(n) asm volatile("s_waitcnt vmcnt(" #n ")" ::: "memory")
#define PG8_WAIT_VN(n) asm volatile("s_waitcnt vmcnt(%0)" :: "n"(n) : "memory")
#define PG8_WAIT_L(n) asm volatile("s_waitcnt lgkmcnt(" #n ")" ::: "memory")
#define PG8_BAR __builtin_amdgcn_s_barrier()
#define PG8_SCHED __builtin_amdgcn_sched_barrier(0)
    Unit cur, nxt; int ui = 0;
    if (!S.next(0, cur)) return;
    f32x4 acc[2][2][4][2];
#pragma unroll
    for (int a = 0; a < 2; ++a)
#pragma unroll
        for (int b = 0; b < 2; ++b)
#pragma unroll
            for (int m = 0; m < 4; ++m)
#pragma unroll
                for (int n = 0; n < 2; ++n) acc[a][b][m][n] = (f32x4){0.f, 0.f, 0.f, 0.f};
    bf16x8 At[4][2], B0[2][2], B1[2][2];
    const char* cA = (const char*)g.A + (size_t)cur.pm * tstepA + (size_t)cur.pn * pnoffA; const char* cB = (const char*)g.Bt + (size_t)cur.pn * tstepB;
    if constexpr (!BPRE) { PG8_STAGE(PG8_SB(0, 0), cB, voffB); PG8_STAGE(PG8_SB(0, 1), cB + hstepB, voffB); } PG8_STAGE(PG8_SA(0, 0), cA, voffA); PG8_STAGE(PG8_SA(0, 1), cA + hstepA, voffA);
    if (wr == 1) PG8_BAR;
    PG8_WAIT_V(2); PG8_BAR;
    if constexpr (!BPRE) PG8_STAGE(PG8_SB(1, 0), cB + kstep, voffB); PG8_STAGE(PG8_SA(1, 0), cA + kstep, voffA); if constexpr (!BPRE) PG8_STAGE(PG8_SB(1, 1), cB + hstepB + kstep, voffB);
    if constexpr (!SHORT) PG8_STAGE(PG8_SA(1, 1), cA + kstep + hstepA, voffA);
    if constexpr (SHORT) PG8_WAIT_V(6); else PG8_WAIT_V(0);
    PG8_BAR;
    for (;;) {
        const bool has_next = S.next(ui + 1, nxt);
        const char* nA = has_next ? (const char*)g.A + (size_t)nxt.pm * tstepA + (size_t)nxt.pn * pnoffA : cA; const char* nB = has_next ? (const char*)g.Bt + (size_t)nxt.pn * tstepB : cB;
#define PG8_SSQ(ON) do { if constexpr (Epi::RSTD_LDS && !SHORT) { if (ON) { const char* sb_ = (const char*)(E.ssq + (size_t)cur.pm * (BM * 16)); \
            _Pragma("unroll") for (int _i = 0; _i < 2; ++_i) asm volatile("s_mov_b32 m0, %2\n\ts_nop 0\n\tglobal_load_lds_dwordx4 %0, %1" :: "v"((unsigned)(wid * 2048 + _i * 1024 + lane * 16)), "s"(sb_), "s"(ldsssq + (unsigned)(_i * 1024)) : "memory"); } } } while (0)
#define PG8_ITER(W1, W2, W3, W4, STG11) do { \
            const bool last = (t == nt - 2); \
            const char* a1 = cA + (size_t)(t + 1) * kstep; \
            const char* a2 = last ? nA : cA + (size_t)(t + 2) * kstep; const char* b2 = last ? nB : cB + (size_t)(t + 2) * kstep; \
            const char* a3 = a2 + kstep; const char* b3 = b2 + kstep; \
              \
            PG8_LDB(B0, 0, 0); PG8_LDB(B1, 0, 1); PG8_SCHED; PG8_LDA(At, 0, 0); if (STG11) PG8_STAGE(PG8_SA(1, 1), a1 + hstepA, voffA); \
            PG8_WAIT_VN(W1); PG8_WAIT_L(0); PG8_BAR; PG8_MMA(0, 0, At, B0); PG8_MMA(0, 1, At, B1); PG8_BAR; PG8_SCHED; \
              \
            PG8_LDA(At, 0, 1); PG8_STAGE(PG8_SB(0, 0), b2, voffB); PG8_STAGE(PG8_SB(0, 1), b2 + hstepB, voffB); PG8_STAGE(PG8_SA(0, 0), a2, voffA); PG8_SSQ(!(STG11)); \
            PG8_WAIT_VN(W2); PG8_WAIT_L(0); PG8_BAR; PG8_MMA(1, 0, At, B0); PG8_MMA(1, 1, At, B1); PG8_BAR; PG8_SCHED; \
              \
            PG8_LDB(B0, 1, 0); PG8_LDB(B1, 1, 1); PG8_SCHED; PG8_LDA(At, 1, 0); PG8_STAGE(PG8_SA(0, 1), a2 + hstepA, voffA); \
            PG8_WAIT_VN(W3); PG8_WAIT_L(0); PG8_BAR; PG8_MMA(0, 0, At, B0); PG8_MMA(0, 1, At, B1); PG8_BAR; PG8_SCHED; \
              \
            PG8_LDA(At, 1, 1); PG8_STAGE(PG8_SB(1, 0), b3, voffB); PG8_STAGE(PG8_SB(1, 1), b3 + hstepB, voffB); PG8_STAGE(PG8_SA(1, 0), a3, voffA); \
            PG8_WAIT_VN(W4); PG8_WAIT_L(0); PG8_BAR; PG8_MMA(1, 0, At, B0); PG8_MMA(1, 1, At, B1); PG8_BAR; PG8_SCHED; } while (0)
        if constexpr (!SHORT) { { const int t = 0; constexpr int X = (Epi::RSTD_LDS ? 2 : 0);
              PG8_ITER(Epi::NSTORES + 2, Epi::NSTORES + 8 + X, Epi::NSTORES + 10 + X, Epi::NSTORES + 14 + X, false); }
            for (int t = 2; t < nt; t += 2) PG8_ITER(8, 8, 8, 8, true);
            PG8_STAGE(PG8_SA(1, 1), nA + kstep + hstepA, voffA); }
        else { for (int t = 0; t < nt; t += 2) PG8_ITER(8, 8, 8, 8, true); }
#undef PG8_ITER
#undef PG8_SSQ
        if constexpr (ALIGN_EPI) { if (wr == 0) PG8_BAR; }
        E(acc, cur, wr, wc, fr, fq);
        if (!has_next) break;
#pragma unroll
        for (int a = 0; a < 2; ++a)
#pragma unroll
            for (int b = 0; b < 2; ++b)
#pragma unroll
                for (int m = 0; m < 4; ++m)
#pragma unroll
                    for (int n = 0; n < 2; ++n) acc[a][b][m][n] = (f32x4){0.f, 0.f, 0.f, 0.f};
        cur = nxt; cA = nA; cB = nB; ++ui;
        if constexpr (ALIGN_EPI) { if (wr == 1) PG8_BAR; }
    }
    PG8_WAIT_V(0);
    if constexpr (!ALIGN_EPI) { if (wr == 0) PG8_BAR; }
    PG8_BAR;
#undef PG8_SA
#undef PG8_SB
#undef PG8_STAGE
#undef PG8_LDA
#undef PG8_LDB
#undef PG8_MMA
#undef PG8_WAIT_V
#undef PG8_WAIT_VN
#undef PG8_WAIT_L
#undef PG8_BAR
#undef PG8_SCHED
}
template <class Epi, class Sched>
__device__ __forceinline__ void prefetch_b(LAS unsigned char* lds, const Gemm g, const Sched& S) {
    int tid_ = threadIdx.x; asm volatile("" : "+v"(tid_));
    const int tid = tid_, wid = __builtin_amdgcn_readfirstlane(tid >> 6);
    Unit u; if (!S.next(0, u)) return;
    const int K = g.K;
    const size_t hstepB = (size_t)HALF * K * 2, kstep = (size_t)(BK * 2);
    const char* cB = (const char*)g.Bt + (size_t)u.pn * (2 * hstepB);
    const unsigned ldsdst = (unsigned)__builtin_amdgcn_readfirstlane((int)((unsigned)(uintptr_t)lds + (unsigned)wid * 1024u));
#pragma unroll
    for (int i = 0; i < 2; ++i) { int R, C; stage_rc(tid * 16 + i * 8192, R, C); const int Rb = Epi::PERM ? ((R & ~31) + perm32(R & 31)) : R;
        const unsigned vo = (unsigned)(Rb * K + C) * 2u;
#pragma unroll
        for (int q = 0; q < 4; ++q) {
            const char* src = cB + (q & 1) * hstepB + (q >> 1) * kstep;
            asm volatile("s_mov_b32 m0, %2\n\ts_nop 0\n\tglobal_load_lds_dwordx4 %0, %1" :: "v"(vo), "s"(src), "s"(ldsdst + (unsigned)((4 + (q >> 1) * 2 + (q & 1)) * HTB + i * 8192)) : "memory"); } }
}
}

namespace att {
typedef LAS const char* lds_cptr;
typedef short v4i16_t __attribute__((ext_vector_type(4)));
constexpr int PITCH = 1024, QB = 128, KVB = 64;
constexpr int KSLOT = 16384, VSLOT = 16384;
constexpr int LDS_V = 3 * KSLOT;
constexpr int LDS_TAB = LDS_V + 3 * VSLOT;
constexpr int LDS_WSF = LDS_TAB + 1152;
constexpr int THR = 8, FIXTHR = 80;
__device__ __forceinline__ int crow(int r, int hi) { return (r & 3) + 8 * (r >> 2) + 4 * hi; }
__device__ __forceinline__ void glds16(const void* gsrc, unsigned lds_dst) { unsigned keep;
    asm volatile("s_mov_b32 %0, m0\n\ts_mov_b32 m0, %2\n\ts_nop 0\n\tglobal_load_lds_dwordx4 %1, off\n\ts_mov_b32 m0, %0" : "=&s"(keep) : "v"(gsrc), "s"(lds_dst) : "memory"); }
__device__ __forceinline__ s16x4 vtr(lds_cptr p) { return __builtin_bit_cast(s16x4, __builtin_amdgcn_ds_read_tr16_b64_v4i16((LAS v4i16_t*)p)); }
#define ATT_WAIT_BAR() asm volatile("s_waitcnt vmcnt(0) lgkmcnt(0)\n\ts_barrier" ::: "memory")
#define ATT_LBAR() asm volatile("s_waitcnt lgkmcnt(0)\n\ts_barrier" ::: "memory")
#define MX3(a, b, c) __builtin_fmaxf(__builtin_fmaxf((a), (b)), (c))
__device__ __forceinline__ float rowmax(const f32x16& p0, const f32x16& p1) {
    float a = MX3(p0[0], p0[1], p1[0]), b = MX3(p0[2], p0[3], p1[1]); a = MX3(a, p1[2], p1[3]);
#pragma unroll
    for (int r = 4; r < 16; r += 4) { a = MX3(a, p0[r], p0[r + 1]); b = MX3(b, p0[r + 2], p0[r + 3]); a = MX3(a, p1[r], p1[r + 1]); b = MX3(b, p1[r + 2], p1[r + 3]); }
    const float m = __builtin_fmaxf(a, b); auto rr = __builtin_amdgcn_permlane32_swap(__float_as_uint(m), __float_as_uint(m), false, false);
    return __builtin_fmaxf(__uint_as_float(rr[0]), __uint_as_float(rr[1]));
}
__device__ __forceinline__ int t5_bucket(int rel) {
    if (rel < 16) return rel;
    int b = 16;
    b += rel >= 19; b += rel >= 21; b += rel >= 24; b += rel >= 27; b += rel >= 31; b += rel >= 35; b += rel >= 40; b += rel >= 46;
    b += rel >= 52; b += rel >= 59; b += rel >= 67; b += rel >= 77; b += rel >= 87; b += rel >= 99; b += rel >= 113;
    return b;
}

__device__ __forceinline__ void attn_unit(int b, int h, int qb, const bf16_t* Q, const bf16_t* K, const bf16_t* V, bf16_t* O, LAS unsigned char* shm,
                                          const float* rel_bias, const float* subg, float lam, unsigned* kmax) {
    int tid_ = threadIdx.x; asm volatile("" : "+v"(tid_));
    const int tid = tid_, lane = tid & 63, r32 = lane & 31, hi = lane >> 5; const int wid = __builtin_amdgcn_readfirstlane(tid >> 6);
    const int mp = wid >> 2, wq = wid & 3;
    const int q0 = qb * QB, qw0 = q0 + 32 * wq;
    const long rowb = (long)b * SEQ;
    const unsigned lds0 = (unsigned)(uintptr_t)shm;
    LAS float* wsf = (LAS float*)(shm + LDS_WSF) + wid * 64;
    LAS float* tab = (LAS float*)(shm + LDS_TAB);
    const float cb = rel_bias[31 * NH + h] * LOG2E;
    if (tid < 288) { const int rel = tid - 64; tab[tid] = rel < 0 ? -INFINITY : (rel < 128 ? (rel_bias[t5_bucket(rel) * NH + h] - rel_bias[31 * NH + h]) * LOG2E : 0.f); }
#define ATT_ISSUE_K(t, koff) do { \
        const long krow_ = ((t) == 0) ? (long)META0 : rowb + 64 * ((t) - 1); \
        const bf16_t* ks_ = K + (krow_ + lane) * PITCH + h * 128 + wid * 8; \
        glds16(ks_, (unsigned)__builtin_amdgcn_readfirstlane(lds0 + (koff) + wid * 1024)); \
        glds16(ks_ + 64, (unsigned)__builtin_amdgcn_readfirstlane(lds0 + (koff) + 8192 + wid * 1024)); } while (0)
#define ATT_ISSUE_V(t, voff) do { \
        const long vrow_ = ((t) == 0) ? (long)META0 : rowb + 64 * ((t) - 1); \
        const bf16_t* vs_ = V + (vrow_ + 16 * (wid & 3) + (lane >> 2)) * PITCH + h * 128 + 32 * (wid >> 2) + (lane & 3) * 8; \
        glds16(vs_, (unsigned)__builtin_amdgcn_readfirstlane(lds0 + LDS_V + (voff) + wid * 1024)); \
        glds16(vs_ + 64, (unsigned)__builtin_amdgcn_readfirstlane(lds0 + LDS_V + (voff) + 8192 + wid * 1024)); } while (0)
    const int NT = 1 + 2 * (qb + 1);
    ATT_ISSUE_K(0, 0); ATT_ISSUE_V(0, 0); ATT_ISSUE_K(1, KSLOT); ATT_ISSUE_V(1, VSLOT); ATT_ISSUE_K(2, 2 * KSLOT);
    bf16x8 qr[4];
    { const bf16_t* Qw = Q + (rowb + qw0 + r32) * PITCH + h * 128 + mp * 64 + hi * 8;
#pragma unroll
      for (int d0 = 0; d0 < 4; ++d0) qr[d0] = *(const bf16x8*)(Qw + d0 * 16); }
    const unsigned kmx_a = __hip_atomic_load(kmax + (b * 8 + h) * 2 + mp, __ATOMIC_RELAXED, __HIP_MEMORY_SCOPE_AGENT), kmx_b = __hip_atomic_load(kmax + 128 + h * 2 + mp, __ATOMIC_RELAXED, __HIP_MEMORY_SCOPE_AGENT);
    const float bv_raw = rel_bias[(lane & 31) * NH + h];
    float mhat = 0.f, l_reg = 0.f;
    f32x16 o[4];
#pragma unroll
    for (int vb = 0; vb < 4; ++vb) o[vb] = f32x16{};
    f32x16 cinit;
#pragma unroll
    for (int r = 0; r < 16; ++r) cinit[r] = cb;
    const lds_cptr shm3 = (lds_cptr)shm;
    const lds_cptr kp0 = shm3 + mp * 8192 + hi * 1024 + r32 * 16;
    const lds_cptr vp0 = shm3 + LDS_V + ((lane >> 4) & 1) * 32 + (lane & 3) * 8 + (4 * hi + ((lane & 15) >> 2)) * 64;
#define SBAR() __builtin_amdgcn_sched_barrier(0)
#define PIN(x) asm volatile("" : "+v"(x))
#define MFMA(a, b, c) __builtin_amdgcn_mfma_f32_32x32x16_bf16(a, b, c, 0, 0, 0)
#define KFR(j) (*(const LAS bf16x8*)(kp_ + ((j) >> 1) * 2048 + ((j) & 1) * 512))
#define KRD(F, j) do { if (F) kf##j = KFR(j); } while (0)
#define PKW(P, B) cvtpk(P[B], P[(B) + 1])
#define EX(v) __builtin_amdgcn_exp2f(v)
#define VRD(dst, h) do { dst[0] = vtr(vp_ + ((h) >> 2) * 4096 + ((h) & 3) * 1024); dst[1] = vtr(vp_ + ((h) >> 2) * 4096 + ((h) & 3) * 1024 + 512); } while (0)
#define VFRAG(src) ((bf16x8){src[0][0], src[0][1], src[0][2], src[0][3], src[1][0], src[1][1], src[1][2], src[1][3]})
#define PAF(k) __builtin_bit_cast(bf16x8, pw##k)
#define GAPA(MF, A0, A1, A2, A3, W0, W1, PW) do { MF; sacc += A0; sacc += A1; sacc += A2; sacc += A3; PIN(sacc); W0; W1; PIN(PW); SBAR(); } while (0)
#define GAPB(VR, KR, MF, X, B) do { VR; KR; MF; X[B] = EX(X[B]); X[(B) + 1] = EX(X[(B) + 1]); PIN(X); SBAR(); } while (0)
#define GAPB0(VR, KR, MF) do { VR; KR; MF; SBAR(); } while (0)
    u32x4 pw0, pw1, pw2, pw3;
    bf16x8 kf0, kf1, kf2, kf3, kf4, kf5, kf6, kf7;
    bool resc = false;
#define PHASE_A(C0, C1, P0, P1, t, DOQK) do { SBAR(); float sacc = P0[0] + P0[1]; \
        if (DOQK) { \
            GAPA(C0 = MFMA(kf0, qr[0], cinit), P0[2], P0[3], P0[4], P0[5],     pw0[0] = PKW(P0, 0),  pw0[1] = PKW(P0, 2),  pw0); \
            GAPA(C1 = MFMA(kf1, qr[0], cinit), P0[6], P0[7], P0[8], P0[9],     pw0[2] = PKW(P0, 4),  pw0[3] = PKW(P0, 6),  pw0); \
            GAPA(C0 = MFMA(kf2, qr[1], C0),    P0[10], P0[11], P0[12], P0[13], pw1[0] = PKW(P0, 8),  pw1[1] = PKW(P0, 10), pw1); \
            GAPA(C1 = MFMA(kf3, qr[1], C1),    P0[14], P0[15], P1[0], P1[1],   pw1[2] = PKW(P0, 12), pw1[3] = PKW(P0, 14), pw1); \
            GAPA(C0 = MFMA(kf4, qr[2], C0),    P1[2], P1[3], P1[4], P1[5],     pw2[0] = PKW(P1, 0),  pw2[1] = PKW(P1, 2),  pw2); \
            GAPA(C1 = MFMA(kf5, qr[2], C1),    P1[6], P1[7], P1[8], P1[9],     pw2[2] = PKW(P1, 4),  pw2[3] = PKW(P1, 6),  pw2); \
            GAPA(C0 = MFMA(kf6, qr[3], C0),    P1[10], P1[11], P1[12], P1[13], pw3[0] = PKW(P1, 8),  pw3[1] = PKW(P1, 10), pw3); \
            GAPA(C1 = MFMA(kf7, qr[3], C1),    P1[14], P1[15], 0.f, 0.f,       pw3[2] = PKW(P1, 12), pw3[3] = PKW(P1, 14), pw3); \
        } else { \
            _Pragma("unroll") for (int r = 2; r < 16; ++r) sacc += P0[r]; _Pragma("unroll") for (int r = 0; r < 16; ++r) sacc += P1[r]; \
            pw0 = (u32x4){PKW(P0, 0), PKW(P0, 2), PKW(P0, 4), PKW(P0, 6)}; pw1 = (u32x4){PKW(P0, 8), PKW(P0, 10), PKW(P0, 12), PKW(P0, 14)}; \
            pw2 = (u32x4){PKW(P1, 0), PKW(P1, 2), PKW(P1, 4), PKW(P1, 6)}; pw3 = (u32x4){PKW(P1, 8), PKW(P1, 10), PKW(P1, 12), PKW(P1, 14)}; } \
        l_reg += sacc; } while (0)
#define MIDDLE(C0, C1, t) do { const int kfirst = 64 * ((t) - 1); \
        if (kfirst + 63 + 113 > qw0) { const LAS float* tb = tab + (64 + qw0 + r32 - kfirst - 4 * hi - 63); \
            _Pragma("unroll") for (int r = 0; r < 16; ++r) { const int c = (r & 3) + 8 * (r >> 2); C0[r] += ((volatile const LAS float*)tb)[63 - c]; C1[r] += ((volatile const LAS float*)tb)[31 - c]; } } \
        resc = false; \
        if (!fixedref) { const float rm = rowmax(C0, C1); \
        if (__builtin_expect(__any(rm > (float)THR), 0)) { const float dl = __builtin_fmaxf(rm, 0.f); mhat += dl; \
            _Pragma("unroll") for (int r = 0; r < 16; ++r) { C0[r] -= dl; C1[r] -= dl; cinit[r] -= dl; } \
            const float f = __builtin_amdgcn_exp2f(-dl); l_reg *= f; if (hi == 0) wsf[r32] = f; resc = true; } } } while (0)
#define PHASE_B(X0, X1, vso, DOEX, RDK) do { SBAR(); const lds_cptr vp_ = vp0 + (vso); const lds_cptr kp_ = kp0 + ks_rd; s16x4 vA[2], vB[2], vC[2]; VRD(vA, 0); VRD(vB, 1); SBAR(); \
        if (DOEX) { \
            GAPB(VRD(vC, 2),  (void)0, o[0] = MFMA(PAF(0), VFRAG(vA), o[0]), X0, 0);  GAPB(VRD(vA, 3),  (void)0, o[0] = MFMA(PAF(1), VFRAG(vB), o[0]), X0, 2); \
            GAPB(VRD(vB, 4),  KRD(RDK, 0),  o[0] = MFMA(PAF(2), VFRAG(vC), o[0]), X0, 4);  GAPB(VRD(vC, 5),  KRD(RDK, 1),  o[0] = MFMA(PAF(3), VFRAG(vA), o[0]), X0, 6); \
            GAPB(VRD(vA, 6),  KRD(RDK, 2),  o[1] = MFMA(PAF(0), VFRAG(vB), o[1]), X0, 8);  GAPB(VRD(vB, 7),  KRD(RDK, 3),  o[1] = MFMA(PAF(1), VFRAG(vC), o[1]), X0, 10); \
            GAPB(VRD(vC, 8),  KRD(RDK, 4),  o[1] = MFMA(PAF(2), VFRAG(vA), o[1]), X0, 12); GAPB(VRD(vA, 9),  KRD(RDK, 5),  o[1] = MFMA(PAF(3), VFRAG(vB), o[1]), X0, 14); \
            GAPB(VRD(vB, 10), KRD(RDK, 6),  o[2] = MFMA(PAF(0), VFRAG(vC), o[2]), X1, 0);  GAPB(VRD(vC, 11), KRD(RDK, 7),  o[2] = MFMA(PAF(1), VFRAG(vA), o[2]), X1, 2); \
            GAPB(VRD(vA, 12), (void)0, o[2] = MFMA(PAF(2), VFRAG(vB), o[2]), X1, 4);  GAPB(VRD(vB, 13), (void)0, o[2] = MFMA(PAF(3), VFRAG(vC), o[2]), X1, 6); \
            GAPB(VRD(vC, 14), (void)0, o[3] = MFMA(PAF(0), VFRAG(vA), o[3]), X1, 8);  GAPB(VRD(vA, 15), (void)0, o[3] = MFMA(PAF(1), VFRAG(vB), o[3]), X1, 10); \
            GAPB((void)0,     (void)0, o[3] = MFMA(PAF(2), VFRAG(vC), o[3]), X1, 12); GAPB((void)0,     (void)0, o[3] = MFMA(PAF(3), VFRAG(vA), o[3]), X1, 14); \
        } else { \
            GAPB0(VRD(vC, 2),  (void)0, o[0] = MFMA(PAF(0), VFRAG(vA), o[0])); GAPB0(VRD(vA, 3),  (void)0, o[0] = MFMA(PAF(1), VFRAG(vB), o[0])); \
            GAPB0(VRD(vB, 4),  KRD(RDK, 0),  o[0] = MFMA(PAF(2), VFRAG(vC), o[0])); GAPB0(VRD(vC, 5),  KRD(RDK, 1),  o[0] = MFMA(PAF(3), VFRAG(vA), o[0])); \
            GAPB0(VRD(vA, 6),  KRD(RDK, 2),  o[1] = MFMA(PAF(0), VFRAG(vB), o[1])); GAPB0(VRD(vB, 7),  KRD(RDK, 3),  o[1] = MFMA(PAF(1), VFRAG(vC), o[1])); \
            GAPB0(VRD(vC, 8),  KRD(RDK, 4),  o[1] = MFMA(PAF(2), VFRAG(vA), o[1])); GAPB0(VRD(vA, 9),  KRD(RDK, 5),  o[1] = MFMA(PAF(3), VFRAG(vB), o[1])); \
            GAPB0(VRD(vB, 10), KRD(RDK, 6),  o[2] = MFMA(PAF(0), VFRAG(vC), o[2])); GAPB0(VRD(vC, 11), KRD(RDK, 7),  o[2] = MFMA(PAF(1), VFRAG(vA), o[2])); \
            GAPB0(VRD(vA, 12), (void)0, o[2] = MFMA(PAF(2), VFRAG(vB), o[2])); GAPB0(VRD(vB, 13), (void)0, o[2] = MFMA(PAF(3), VFRAG(vC), o[2])); \
            GAPB0(VRD(vC, 14), (void)0, o[3] = MFMA(PAF(0), VFRAG(vA), o[3])); GAPB0(VRD(vA, 15), (void)0, o[3] = MFMA(PAF(1), VFRAG(vB), o[3])); \
            GAPB0((void)0,     (void)0, o[3] = MFMA(PAF(2), VFRAG(vC), o[3])); GAPB0((void)0,     (void)0, o[3] = MFMA(PAF(3), VFRAG(vA), o[3])); \
        } } while (0)
#define RESC() do { if (resc) { asm volatile("s_waitcnt lgkmcnt(0)" ::: "memory"); \
        _Pragma("unroll") for (int r = 0; r < 16; ++r) { const float fr_ = wsf[crow(r, hi)]; \
            _Pragma("unroll") for (int vb = 0; vb < 4; ++vb) o[vb][r] *= fr_; } } } while (0)
    int vs_prev = 0, vs_next = 2 * VSLOT;
    int ks_rd = 2 * KSLOT, ks_is = 0;
#define ROT() do { vs_prev = (vs_prev == 2 * VSLOT) ? 0 : vs_prev + VSLOT; vs_next = (vs_next == 2 * VSLOT) ? 0 : vs_next + VSLOT; \
        ks_rd = ks_is; ks_is = (ks_is == 2 * KSLOT) ? 0 : ks_is + KSLOT; } while (0)
#define STEP(C0, C1, P0, P1, t, DOQK, RDK) do { \
        if ((t) + 2 < NT) ATT_ISSUE_K((t) + 2, ks_is);     \
        if ((t) + 1 < NT) ATT_ISSUE_V((t) + 1, vs_next);   \
        PHASE_A(C0, C1, P0, P1, t, DOQK); \
        if (DOQK) { MIDDLE(C0, C1, t); } else resc = false; \
        PHASE_B(C0, C1, vs_prev, DOQK, RDK); \
        ATT_WAIT_BAR(); RESC(); ROT(); } while (0)
    f32x16 sA0, sA1, sB0, sB1;
    ATT_WAIT_BAR();
    { const lds_cptr kp_ = kp0; sA0 = cinit;
#pragma unroll
      for (int d0 = 0; d0 < 4; ++d0) sA0 = MFMA(KFR(2 * d0), qr[d0], sA0);
      if (q0 == 0) { const LAS float* tb = tab + (64 + qw0 + r32 + NMETA - 4 * hi - 11);
#pragma unroll
          for (int r = 0; r < 8; ++r) sA0[r] += ((volatile const LAS float*)tb)[11 - ((r & 3) + 8 * (r >> 2))]; }
      float a = MX3(sA0[0], sA0[1], sA0[2]), bq = MX3(sA0[3], sA0[4], sA0[5]); a = MX3(a, sA0[6], sA0[7]); float rm = __builtin_fmaxf(a, bq);
      { auto rr = __builtin_amdgcn_permlane32_swap(__float_as_uint(rm), __float_as_uint(rm), false, false); rm = __builtin_fmaxf(__uint_as_float(rr[0]), __uint_as_float(rr[1])); }
      mhat = rm;
#pragma unroll
      for (int r = 0; r < 16; ++r) cinit[r] -= rm;
#pragma unroll
      for (int r = 0; r < 8; ++r) sA0[r] = EX(sA0[r] - rm);
#pragma unroll
      for (int r = 8; r < 16; ++r) sA0[r] = 0.f;
#pragma unroll
      for (int r = 0; r < 16; ++r) sA1[r] = 0.f;
      { const lds_cptr kp_ = kp0 + KSLOT; kf0 = KFR(0); kf1 = KFR(1); kf2 = KFR(2); kf3 = KFR(3); kf4 = KFR(4); kf5 = KFR(5); kf6 = KFR(6); kf7 = KFR(7); } }
    ATT_WAIT_BAR();
    const bool last_act = (wq >= 2);
    bool fixedref;
    { float q1 = 0.f;
#pragma unroll
      for (int d0 = 0; d0 < 4; ++d0)
#pragma unroll
          for (int e = 0; e < 8; ++e) q1 += __builtin_fabsf(__uint_as_float(((unsigned)(unsigned short)qr[d0][e]) << 16));
      { auto rr = __builtin_amdgcn_permlane32_swap(__float_as_uint(q1), __float_as_uint(q1), false, false); q1 = __uint_as_float(rr[0]) + __uint_as_float(rr[1]); }
      const float kmx = __builtin_fmaxf(__uint_as_float(kmx_a), __uint_as_float(kmx_b)) * 1.01f;
      float bv = (lane < 32) ? bv_raw * LOG2E : -INFINITY;
#pragma unroll
      for (int o = 1; o < 32; o <<= 1) bv = __builtin_fmaxf(bv, __shfl_xor(bv, o));
      const float bmax = __shfl(bv, 0);
      fixedref = __all(q1 * kmx + bmax - mhat <= (float)FIXTHR) != 0; }
    int t = 1;
    for (; t + 2 < NT; t += 2) {
        STEP(sB0, sB1, sA0, sA1, t, true, true);
        STEP(sA0, sA1, sB0, sB1, t + 1, true, true);
    }
    STEP(sB0, sB1, sA0, sA1, t, true, true);
    STEP(sA0, sA1, sB0, sB1, t + 1, last_act, false);
    if (last_act) { resc = false; PHASE_A(sB0, sB1, sA0, sA1, NT, false); PHASE_B(sB0, sB1, vs_prev, false, false); }
#undef STEP
#undef ROT
#undef RESC
#undef PHASE_B
#undef MIDDLE
#undef PHASE_A
#undef GAPB0
#undef GAPB
#undef GAPA
#undef PAF
#undef VFRAG
#undef VRD
#undef EX
#undef PKW
#undef KFR
#undef MFMA
#undef PIN
#undef SBAR
#undef ATT_ISSUE_K
#undef ATT_ISSUE_V
#undef KRD
    { auto rr = __builtin_amdgcn_permlane32_swap(__float_as_uint(l_reg), __float_as_uint(l_reg), false, false); l_reg = __uint_as_float(rr[0]) + __uint_as_float(rr[1]); }
    if (hi == 0) wsf[32 + r32] = l_reg;
    asm volatile("s_waitcnt lgkmcnt(0)" ::: "memory");
    const float msc = mp ? lam : 1.0f;
    float rli[16];
#pragma unroll
    for (int r = 0; r < 16; ++r) rli[r] = msc * __builtin_amdgcn_rcpf(wsf[32 + crow(r, hi)]);
    ATT_WAIT_BAR();
    { LAS float* stg = (LAS float*)shm + mp * (QB * 128) + (32 * wq) * 128 + r32;
#pragma unroll
      for (int vb = 0; vb < 4; ++vb)
#pragma unroll
          for (int r = 0; r < 16; ++r) stg[crow(r, hi) * 128 + 32 * vb] = o[vb][r] * rli[r]; }
    ATT_LBAR();
    { const int row = tid >> 2, seg = tid & 3;
      const LAS f32x4* a = (const LAS f32x4*)((LAS float*)shm + row * 128 + seg * 32);
      const LAS f32x4* c = (const LAS f32x4*)((LAS float*)shm + QB * 128 + row * 128 + seg * 32);
      f32x4 dv[8]; float ss = 0.f;
#pragma unroll
      for (int i = 0; i < 8; ++i) { dv[i] = a[i] - c[i]; ss += (dv[i][0] * dv[i][0] + dv[i][1] * dv[i][1]) + (dv[i][2] * dv[i][2] + dv[i][3] * dv[i][3]); }
      ss += __shfl_xor(ss, 1); ss += __shfl_xor(ss, 2);
      const float rs = __builtin_amdgcn_rsqf(ss * (1.0f / 128.0f) + RMS_EPS) * (1.0f - LAMBDA_INIT);
      bf16_t* op = O + (rowb + q0 + row) * PITCH + h * 128 + seg * 32;
      const f32x4* gp = (const f32x4*)(subg + seg * 32);
#pragma unroll
      for (int i = 0; i < 4; ++i) { const f32x4 g0 = gp[2 * i], g1 = gp[2 * i + 1]; const f32x4 v0 = dv[2 * i] * rs * g0, v1 = dv[2 * i + 1] * rs * g1;
          u32x4 w; w.x = cvtpk(v0[0], v0[1]); w.y = cvtpk(v0[2], v0[3]); w.z = cvtpk(v1[0], v1[1]); w.w = cvtpk(v1[2], v1[3]);
          *(u32x4*)(op + 8 * i) = w; } }
    ATT_LBAR();
}
#undef MX3
}

namespace mrow {
template <int NB, int KSTEPS>
__device__ __forceinline__ bool partial_reduce(const bf16_t* A, int lda, const bf16_t* Bt, int K, const int (&nrow)[NB], int wave, int lane, LAS f32x4* red, f32x4 (&acc)[NB]) {
    const int fr = lane & 15, fq = lane >> 4;
    const size_t koff = (size_t)wave * (KSTEPS * 32) + fq * 8;
    const bf16_t* ap = A + (size_t)fr * lda + koff;
#pragma unroll
    for (int nb = 0; nb < NB; ++nb) acc[nb] = (f32x4){0.f, 0.f, 0.f, 0.f};
    constexpr int CH = 4;
#pragma unroll
    for (int s0 = 0; s0 < KSTEPS; s0 += CH) {
        bf16x8 a[CH], b[NB][CH];
#pragma unroll
        for (int c = 0; c < CH; ++c) if (s0 + c < KSTEPS) a[c] = *(const bf16x8*)(ap + (s0 + c) * 32);
#pragma unroll
        for (int nb = 0; nb < NB; ++nb)
#pragma unroll
            for (int c = 0; c < CH; ++c) if (s0 + c < KSTEPS) b[nb][c] = *(const bf16x8*)(Bt + (size_t)(nrow[nb] + fr) * K + koff + (s0 + c) * 32);
#pragma unroll
        for (int nb = 0; nb < NB; ++nb)
#pragma unroll
            for (int c = 0; c < CH; ++c) if (s0 + c < KSTEPS) acc[nb] = __builtin_amdgcn_mfma_f32_16x16x32_bf16(b[nb][c], a[c], acc[nb], 0, 0, 0);
        __builtin_amdgcn_sched_barrier(0);
    }
#pragma unroll
    for (int nb = 0; nb < NB; ++nb) red[(wave * NB + nb) * 64 + lane] = acc[nb];
    __syncthreads();
    if (wave != 0) return false;
#pragma unroll
    for (int nb = 0; nb < NB; ++nb) { f32x4 t = red[nb * 64 + lane];
#pragma unroll
        for (int w = 1; w < 8; ++w) t += red[(w * NB + nb) * 64 + lane];
        acc[nb] = t; }
    return true;
}
}

#ifndef REP_GU
#define REP_GU 1
#endif
#ifndef REP_MISC
#define REP_MISC 1
#endif
#ifndef REP_P5
#define REP_P5 1
#endif
#ifndef PHASE_MASK
#define PHASE_MASK 0x3ff
#endif
constexpr int NWAVES = 8;
constexpr size_t MiB = 1u << 20;
constexpr size_t WS_CTL = 0, CTL_ZERO_BYTES = 1 * MiB;
constexpr size_t WS_WPOOL = 1 * MiB, WS_WGU0 = 2 * MiB, WS_WD0 = 13 * MiB, WS_WQKV = 19 * MiB, WS_WO = 25 * MiB, WS_WGU1 = 27 * MiB, WS_WD1 = 38 * MiB;
constexpr size_t WS_SSQ = 44 * MiB;
constexpr size_t WS_H = 48 * MiB;
constexpr size_t WS_HB = 178 * MiB;
constexpr size_t WS_ACT = 243 * MiB;
constexpr size_t QKV_STRIDE = (size_t)MPAD * D;
constexpr size_t WS_O = 437 * MiB;
constexpr size_t WS_END = 502 * MiB;
static_assert(WS_WGU0 + (size_t)2 * FF * D * 2 <= WS_WD0 && WS_WD0 + (size_t)FF * D * 2 <= WS_WQKV && WS_WQKV + (size_t)3 * D * D * 2 <= WS_WO && WS_WO + (size_t)D * D * 2 <= WS_WGU1, "ws map");
static_assert(WS_WGU1 + (size_t)2 * FF * D * 2 <= WS_WD1 && WS_WD1 + (size_t)FF * D * 2 <= WS_SSQ && WS_SSQ + (size_t)MPAD * 16 * 4 <= WS_H && WS_H + (size_t)MPAD * D * 4 <= WS_HB, "ws map");
static_assert(WS_HB + (size_t)MPAD * D * 2 <= WS_ACT && WS_ACT + (size_t)MPAD * FF * 2 <= WS_END && WS_ACT + 3 * QKV_STRIDE * 2 <= WS_O && WS_O + (size_t)MMAIN * D * 2 <= WS_END, "ws map");
constexpr int CW_BAR = 4096;
constexpr int CW_KMAX = 65536;

constexpr int RING_OFF = 0, RING_BYTES = 131072;
constexpr int LDSCTL_OFF = RING_BYTES, MISC_OFF = LDSCTL_OFF + 320;
constexpr int LDS_BYTES = 163840;

typedef GAS unsigned gu32;
#define RLX_AGENT __ATOMIC_RELAXED, __HIP_MEMORY_SCOPE_AGENT
#define LDS_WAIT() asm volatile("s_waitcnt lgkmcnt(0)" ::: "memory")

#define XB_TMO      128
#define XB_XCNT(j)  (256  + 64 * (j))
#define XB_XSUB(j)  (1280 + 64 * (j))
#define XB_XGEN(j)  (2304 + 64 * (j))
#define XB_TOP      3328
#define XB_TOPGEN   3392
#define XCD_BAR_WORDS 3456
#define XB_SPIN_CAP (1u << 18)
__device__ __forceinline__ unsigned xb_ld(unsigned* p)              { return __hip_atomic_load(p, __ATOMIC_RELAXED, __HIP_MEMORY_SCOPE_AGENT); }
__device__ __forceinline__ unsigned xb_add(unsigned* p, unsigned v) { return __hip_atomic_fetch_add(p, v, __ATOMIC_RELAXED, __HIP_MEMORY_SCOPE_AGENT); }
__device__ __forceinline__ unsigned xb_xcc_id() { return (unsigned)__builtin_amdgcn_s_getreg((3 << 11) | 20) & 0xFu; }
#define XB_SPIN(cond, bar) do { unsigned _sp = 0; while (cond) { __builtin_amdgcn_s_sleep(1); \
    if ((++_sp & 255u) == 0u) { if (xb_ld(&(bar)[XB_TMO])) break; if (_sp > XB_SPIN_CAP) { atomicAdd(&(bar)[XB_TMO], 1u); break; } } } } while (0)
struct XcdBarrier { unsigned* bar; unsigned x; volatile LAS unsigned* st; };
__device__ __forceinline__ XcdBarrier xcd_barrier_post(unsigned* bar, volatile LAS unsigned* st) {
    XcdBarrier b; b.bar = bar; b.x = xb_xcc_id(); b.st = st;
    if (threadIdx.x == 0) (void)xb_add(&bar[XB_XCNT(b.x)], 1u);
    return b;
}
__device__ __forceinline__ void xcd_barrier_complete(unsigned* bar, unsigned x, unsigned& nloc, unsigned& nx) {
    const unsigned G = gridDim.x * gridDim.y * gridDim.z;
    unsigned sum, cnt, mine, sp = 0u;
    for (;;) {
        sum = 0u; cnt = 0u; mine = 0u;
#pragma unroll
        for (unsigned j = 0; j < 16; ++j) { const unsigned c = xb_ld(&bar[XB_XCNT(j)]); sum += c; cnt += (c > 0u) ? 1u : 0u; mine = (j == x) ? c : mine; }
        if (sum == G) break;
        __builtin_amdgcn_s_sleep(1);
        if ((++sp & 255u) == 0u) { if (xb_ld(&bar[XB_TMO])) break; if (sp > XB_SPIN_CAP) { atomicAdd(&bar[XB_TMO], 1u); break; } }
    }
    nloc = mine > 0u ? mine : 1u; nx = cnt > 0u ? cnt : 1u;
}
template <class F>
__device__ __forceinline__ void xcd_barrier_pf(const XcdBarrier& b, F&& between) {
    asm volatile("s_waitcnt vmcnt(0)" ::: "memory");
    __syncthreads();
    unsigned target = 0u;
    if (threadIdx.x == 0) {
        unsigned* bar = b.bar;
        __builtin_amdgcn_s_waitcnt(0);
        unsigned nloc = b.st[0], nx = b.st[1];
        if (nloc == 0u) { xcd_barrier_complete(bar, b.x, nloc, nx); b.st[0] = nloc; b.st[1] = nx; }
        asm volatile("buffer_inv sc1" ::: "memory");
        const unsigned old = xb_add(&bar[XB_XSUB(b.x)], 1u);
        const unsigned gen = old / nloc;
        if (old + 1u == (gen + 1u) * nloc) {
            __builtin_amdgcn_fence(__ATOMIC_RELEASE, "agent");
            asm volatile("s_waitcnt vmcnt(0)" ::: "memory");
            (void)xb_add(&bar[XB_TOP], 1u);
        }
        target = (gen + 1u) * nx;
    }
    between();
    if (threadIdx.x == 0) {
        unsigned* bar = b.bar;
        XB_SPIN(xb_ld(&bar[XB_TOP]) < target, bar);
        asm volatile("s_waitcnt vmcnt(0)" ::: "memory");
    }
    __syncthreads();
}
__device__ __forceinline__ void xcd_barrier(const XcdBarrier& b) { xcd_barrier_pf(b, [] {}); }

struct Args { const float* in[18]; float* out; unsigned char* ws; };

__device__ __forceinline__ void transpose_item(const float* W, int ldw, int k0, int n0, bf16_t* WT, int ldt, int wt_row0, const float* kgain, const float* nscale, LAS float* scr, int lane) {
    const int c4 = (lane & 7) * 4, kr = lane >> 3;
    f32x4 v[8];
#pragma unroll
    for (int i = 0; i < 8; ++i) v[i] = *(const f32x4*)(W + (size_t)(k0 + kr + 8 * i) * ldw + n0 + c4);
    f32x4 ns = {1.f, 1.f, 1.f, 1.f};
    if (nscale) ns = *(const f32x4*)(nscale + n0 + c4);
#pragma unroll
    for (int i = 0; i < 8; ++i) { const int kk = kr + 8 * i; f32x4 t = v[i] * ns; if (kgain) t = t * kgain[k0 + kk];
        LAS float* d = scr + kk * 33 + c4; d[0] = t[0]; d[1] = t[1]; d[2] = t[2]; d[3] = t[3]; }
    LDS_WAIT(); asm volatile("" ::: "memory");
    const int c = lane & 7;
#pragma unroll
    for (int j = 0; j < 4; ++j) { const int n = (lane >> 3) + 8 * j; const LAS float* sp = scr + (8 * c) * 33 + n;
        u32x4 o; o[0] = cvtpk(sp[0 * 33], sp[1 * 33]); o[1] = cvtpk(sp[2 * 33], sp[3 * 33]); o[2] = cvtpk(sp[4 * 33], sp[5 * 33]); o[3] = cvtpk(sp[6 * 33], sp[7 * 33]);
        *(u32x4*)(WT + (size_t)(wt_row0 + n0 + n) * ldt + k0 + 8 * c) = o; }
    LDS_WAIT(); asm volatile("" ::: "memory");
}

__global__ void __launch_bounds__(NWAVES * 64, 2) fwd_megakernel(Args args) {
    extern __shared__ __attribute__((aligned(16))) unsigned char lds_raw[];
    LAS unsigned char* lds = (LAS unsigned char*)lds_raw;
    volatile LAS unsigned* MISC = (volatile LAS unsigned*)(lds + MISC_OFF);
    const int tid = threadIdx.x, lane = tid & 63, wave = __builtin_amdgcn_readfirstlane(tid >> 6);
    const int G = gridDim.x; const int bx = blockIdx.x; const int vcu = (G % 8 == 0) ? (bx % 8) * (G / 8) + bx / 8 : bx;
    gu32* ctl = (gu32*)(args.ws + WS_CTL);
#define x          (args.in[0])
#define meta       (args.in[1])
#define rel_bias   (args.in[2])
#define mix_g      (args.in[3])
#define ffn_g      (args.in[4])
#define pool_w     (args.in[5])
#define pool_scale (args.in[6])
#define w_qkv      (args.in[7])
#define w_o        (args.in[8])
#define lq1        (args.in[9])
#define lk1        (args.in[10])
#define lq2        (args.in[11])
#define lk2        (args.in[12])
#define subg       (args.in[13])
#define w_gate     (args.in[14])
#define w_up       (args.in[15])
#define w_down     (args.in[16])
#define fin_g      (args.in[17])
#define Wpool ((bf16_t*)(args.ws + WS_WPOOL))
#define Wgu0  ((bf16_t*)(args.ws + WS_WGU0))
#define Wd0   ((bf16_t*)(args.ws + WS_WD0))
#define Wqkv  ((bf16_t*)(args.ws + WS_WQKV))
#define Wo    ((bf16_t*)(args.ws + WS_WO))
#define Wgu1  ((bf16_t*)(args.ws + WS_WGU1))
#define Wd1   ((bf16_t*)(args.ws + WS_WD1))
#define SSQ   ((float*)(args.ws + WS_SSQ))
#define H     ((float*)(args.ws + WS_H))
#define HB    ((bf16_t*)(args.ws + WS_HB))
#define ACT   ((bf16_t*)(args.ws + WS_ACT))
#define QB_   ((bf16_t*)(args.ws + WS_ACT))
#define KB_   (QB_ + QKV_STRIDE)
#define VB_   (KB_ + QKV_STRIDE)
#define OB_   ((bf16_t*)(args.ws + WS_O))
    for (int u = tid; u < (LDS_BYTES - LDSCTL_OFF) / 4; u += NWAVES * 64) ((LAS unsigned*)(lds + LDSCTL_OFF))[u] = 0u;
    __syncthreads();
    XcdBarrier bar = xcd_barrier_post((unsigned*)(ctl + CW_BAR), MISC + 8);
    const int gw = vcu * NWAVES + wave, NGW = G * NWAVES;

    constexpr int I_POOL = 128, I_GU = 1408, I_DN = 1408, I_QKV = 1536, I_WO = 512;
#define CONVERT_ITEM(it_, scr_) do { int r = (it_); \
        if (r < I_POOL) { const int g = r >> 5, q = r & 31, kb = q >> 3, nb = q & 7; \
            transpose_item(pool_w + (size_t)g * 65536, 256, 64 * kb, 32 * nb, Wpool, 256, g * 256, nullptr, pool_scale + g * 256, scr_, lane); break; } \
        r -= I_POOL; \
        if (r < 4 * I_GU) { const int which = r / I_GU, q = r % I_GU, layer = which >> 1, isup = which & 1, kb = q / 88, nb = q % 88, n0 = 32 * nb; \
            const float* W = (isup ? w_up : w_gate) + (size_t)layer * D * FF; \
            transpose_item(W, FF, 64 * kb, n0, layer ? Wgu1 : Wgu0, D, 256 * (n0 >> 7) + 128 * isup + (n0 & 127) - n0, ffn_g + layer * D, nullptr, scr_, lane); break; } \
        r -= 4 * I_GU; \
        if (r < 2 * I_DN) { const int layer = r / I_DN, q = r % I_DN, kb = q >> 5, nb = q & 31; \
            transpose_item(w_down + (size_t)layer * FF * D, D, 64 * kb, 32 * nb, layer ? Wd1 : Wd0, FF, 0, nullptr, nullptr, scr_, lane); break; } \
        r -= 2 * I_DN; \
        if (r < I_QKV) { const int kb = r / 96, nb = r % 96; \
            transpose_item(w_qkv, 3 * D, 64 * kb, 32 * nb, Wqkv, D, 0, mix_g + D, nullptr, scr_, lane); break; } \
        r -= I_QKV; \
        { const int kb = r >> 5, nb = r & 31; transpose_item(w_o, D, 64 * kb, 32 * nb, Wo, D, 0, nullptr, nullptr, scr_, lane); } } while (0)
    if (PHASE_MASK & (1 << 0))
    {
        LAS float* scr = (LAS float*)(lds + RING_OFF + wave * 16384);
        constexpr int N_EARLY = I_POOL + 2 * I_GU + I_DN + I_QKV;
        for (int e = gw; e < N_EARLY; e += NGW) {
            const int it = e < I_POOL + 2 * I_GU ? e : (e < I_POOL + 2 * I_GU + I_DN ? e + 2 * I_GU : e + 2 * I_GU + I_DN);
            CONVERT_ITEM(it, scr);
        }
        __syncthreads();
        LAS float* hn = (LAS float*)(lds + RING_OFF);
        f32x4 gv[4];
#pragma unroll
        for (int j = 0; j < 4; ++j) gv[j] = *((const f32x4*)mix_g + lane + 64 * j);
        const int pg = tid >> 7, pw_ = 2 << pg;
        const LAS f32x2* pcol = (const LAS f32x2*)hn + tid;
#define POOL_SRC(b_, p_) (((p_) < NMETA) ? meta + (size_t)(p_) * D : x + ((size_t)(b_) * SEQ + ((p_) - NMETA)) * D)
#define POOL_LOAD(dst, src0, src1) do { const f32x4* a_ = (const f32x4*)(src0) + lane; const f32x4* b_ = (const f32x4*)(src1) + lane; \
            _Pragma("unroll") for (int j = 0; j < 4; ++j) { dst[j] = a_[64 * j]; dst[4 + j] = b_[64 * j]; } } while (0)
#define POOL_NORM_STORE(src, half) do { float s0_ = 0.f, s1_ = 0.f; \
            _Pragma("unroll") for (int j = 0; j < 4; ++j) { s0_ += (src[j][0] * src[j][0] + src[j][1] * src[j][1]) + (src[j][2] * src[j][2] + src[j][3] * src[j][3]); \
                                                            s1_ += (src[4 + j][0] * src[4 + j][0] + src[4 + j][1] * src[4 + j][1]) + (src[4 + j][2] * src[4 + j][2] + src[4 + j][3] * src[4 + j][3]); } \
            const float r0_ = __builtin_amdgcn_rsqf(wave_sum(s0_) * (1.0f / D) + RMS_EPS), r1_ = __builtin_amdgcn_rsqf(wave_sum(s1_) * (1.0f / D) + RMS_EPS); \
            LAS f32x4* d0_ = (LAS f32x4*)(hn + ((half) * 16 + 2 * wave) * 1024) + lane; \
            _Pragma("unroll") for (int j = 0; j < 4; ++j) { d0_[64 * j] = src[j] * r0_ * gv[j]; d0_[256 + 64 * j] = src[4 + j] * r1_ * gv[j]; } } while (0)
        for (int run = vcu; run < MMAIN / 128; run += G) {
            const int b = run >> 5, t0 = (run & 31) * 128;
            f32x4 RA[8], RB[8], RC[8];
            { const int p0_ = NMETA + t0 - 16 + 2 * wave; POOL_LOAD(RA, POOL_SRC(b, p0_), POOL_SRC(b, p0_ + 1)); }
            { const int p0_ = NMETA + t0 + 2 * wave; POOL_LOAD(RB, POOL_SRC(b, p0_), POOL_SRC(b, p0_ + 1)); }
            { const int p0_ = NMETA + t0 + 16 + 2 * wave; POOL_LOAD(RC, POOL_SRC(b, p0_), POOL_SRC(b, p0_ + 1)); }
            POOL_NORM_STORE(RA, 1);
#define POOL_STEP(st, Rcur, Rfree) do { const int half = (st) & 1; \
                POOL_NORM_STORE(Rcur, half); \
                if ((st) + 2 < 8) { const int p0_ = NMETA + t0 + 16 * ((st) + 2) + 2 * wave; POOL_LOAD(Rfree, POOL_SRC(b, p0_), POOL_SRC(b, p0_ + 1)); } \
                __syncthreads(); \
                { const int rb = 16 * half; f32x2 sm = {0.f, 0.f}; \
                  for (int i = 1; i < pw_; ++i) sm += pcol[((rb - i) & 31) * 512]; \
                  const float invw = 1.0f / (float)pw_; const size_t orow0 = (size_t)b * SEQ + t0 + 16 * (st); \
                  _Pragma("unroll") for (int o = 0; o < 16; ++o) { const f32x2 cur = pcol[(rb + o) * 512]; sm += cur; const f32x2 pv = sm * invw - cur; \
                      *(unsigned*)(HB + (orow0 + o) * D + 2 * tid) = cvtpk(pv[0], pv[1]); sm -= pcol[((rb + o - pw_ + 1) & 31) * 512]; } } \
                __syncthreads(); } while (0)
            POOL_STEP(0, RB, RA); POOL_STEP(1, RC, RB); POOL_STEP(2, RA, RC); POOL_STEP(3, RB, RA);
            POOL_STEP(4, RC, RB); POOL_STEP(5, RA, RC); POOL_STEP(6, RB, RA); POOL_STEP(7, RC, RB);
#undef POOL_STEP
        }
        if (vcu == 0) {
            f32x4 R[8];
            POOL_LOAD(R, meta + (size_t)(2 * wave) * D, meta + (size_t)(2 * wave + 1) * D);
            POOL_NORM_STORE(R, 0);
            { LAS f32x4* z = (LAS f32x4*)(hn + (16 + 2 * wave) * 1024) + lane;
#pragma unroll
              for (int j = 0; j < 8; ++j) z[64 * j] = (f32x4){0.f, 0.f, 0.f, 0.f}; }
            __syncthreads();
            f32x2 sm = {0.f, 0.f};
#pragma unroll
            for (int o = 0; o < 16; ++o) {
                const f32x2 cur = pcol[o * 512];
                sm += cur;
                const float ic = 1.0f / (float)((o + 1) < pw_ ? (o + 1) : pw_);
                const f32x2 pv = sm * ic - cur;
                *(unsigned*)(HB + ((size_t)META0 + o) * D + 2 * tid) = cvtpk(pv[0], pv[1]);
                sm -= pcol[((o - pw_ + 1) & 31) * 512];
            }
            __syncthreads();
        }
#undef POOL_SRC
#undef POOL_LOAD
#undef POOL_NORM_STORE
        for (int r = META0 + NMETA + gw; r < MPAD; r += NGW) { u32x4* p = (u32x4*)(HB + (size_t)r * D) + lane * 2; p[0] = (u32x4){0u, 0u, 0u, 0u}; p[1] = (u32x4){0u, 0u, 0u, 0u}; }
    }
    xcd_barrier(bar);

    if (PHASE_MASK & (1 << 1))
    {
        pg8::Gemm g{HB, Wpool, MPAD, D, 256, D, 256, MMAIN / 256}; pg8::StaticOrder S; S.init(MMAIN, D, G, bx);
        pg8::EpiRes E{x, MMAIN, meta, NMETA, nullptr, HB, SSQ};
        pg8::gemm_phase<pg8::EpiRes, pg8::StaticOrder, true>(lds + RING_OFF, g, S, E);
        pg8::MetaOrder SM{MMAIN / 256, D / 256, bx};
        pg8::gemm_phase<pg8::EpiRes, pg8::MetaOrder, true, true>(lds + RING_OFF, g, SM, E);
    }
    { pg8::Gemm gn_{HB, Wgu0, MPAD, 2 * FF, D, D, 0, MMAIN / 256}; pg8::StaticOrder Sn_; Sn_.init(MMAIN, 2 * FF, G, bx);
      xcd_barrier_pf(bar, [&] { pg8::prefetch_b<pg8::EpiSwiGLU, pg8::StaticOrder>(lds + RING_OFF, gn_, Sn_); }); }
    if (PHASE_MASK & (1 << 2))
    {
        pg8::Gemm g{HB, Wgu0, MPAD, 2 * FF, D, D, 0, MMAIN / 256}; pg8::StaticOrder S; S.init(MMAIN, 2 * FF, G, bx);
        pg8::EpiSwiGLU E{ACT, SSQ, (LAS const unsigned char*)(lds + RING_OFF + pg8::SSQ_LDS)};
        for (int rep = 0; rep < REP_GU; ++rep)
        pg8::gemm_phase<pg8::EpiSwiGLU, pg8::StaticOrder, true, false, true>(lds + RING_OFF, g, S, E);
        if (bx < FF / 16) {
            const int f0 = bx * 16; const int nrow[2] = {256 * (f0 >> 7) + (f0 & 127), 256 * (f0 >> 7) + 128 + (f0 & 127)};
            f32x4 macc[2];
            if (mrow::partial_reduce<2, D / 256>(HB + (size_t)META0 * D, D, Wgu0, D, nrow, wave, lane, (LAS f32x4*)(lds + RING_OFF), macc)) {
                const int row = META0 + (lane & 15); const float rs = pg8::row_rstd(SSQ, row);
                float o[4];
#pragma unroll
                for (int e = 0; e < 4; ++e) { const float gt = macc[0][e] * rs, up = macc[1][e] * rs; o[e] = gt * __builtin_amdgcn_rcpf(1.0f + __builtin_amdgcn_exp2f(-gt * LOG2E)) * up; }
                *(u32x2*)(ACT + (size_t)row * FF + f0 + 4 * (lane >> 4)) = (u32x2){cvtpk(o[0], o[1]), cvtpk(o[2], o[3])};
            }
            __syncthreads();
        }
    }
    { pg8::Gemm gn_{ACT, Wd0, MPAD, D, FF, FF, 0, MMAIN / 256}; pg8::StaticOrder Sn_; Sn_.init(MMAIN, D, G, bx);
      xcd_barrier_pf(bar, [&] { pg8::prefetch_b<pg8::EpiRes, pg8::StaticOrder>(lds + RING_OFF, gn_, Sn_); }); }
    if (PHASE_MASK & (1 << 3))
    {
        pg8::Gemm g{ACT, Wd0, MPAD, D, FF, FF, 0, MMAIN / 256}; pg8::StaticOrder S; S.init(MMAIN, D, G, bx);
        pg8::EpiRes E{nullptr, 0, nullptr, 0, HB, HB, SSQ};
        pg8::gemm_phase<pg8::EpiRes, pg8::StaticOrder, true, false, true>(lds + RING_OFF, g, S, E);
        if (bx < 16) {
            const int nrow[4] = {bx * 64, bx * 64 + 16, bx * 64 + 32, bx * 64 + 48};
            f32x4 macc[4];
            if (mrow::partial_reduce<4, FF / 256>(ACT + (size_t)META0 * FF, FF, Wd0, FF, nrow, wave, lane, (LAS f32x4*)(lds + RING_OFF), macc)) {
                const int row = META0 + (lane & 15); float ss = 0.f;
#pragma unroll
                for (int nb = 0; nb < 4; ++nb) { bf16_t* hp = HB + (size_t)row * D + nrow[nb] + 4 * (lane >> 4); const u32x2 rb = *(const u32x2*)hp;
                    const float v0 = macc[nb][0] + __uint_as_float(rb[0] << 16), v1 = macc[nb][1] + __uint_as_float(rb[0] & 0xffff0000u), v2 = macc[nb][2] + __uint_as_float(rb[1] << 16), v3 = macc[nb][3] + __uint_as_float(rb[1] & 0xffff0000u);
                    *(u32x2*)hp = (u32x2){cvtpk(v0, v1), cvtpk(v2, v3)}; ss += (v0 * v0 + v1 * v1) + (v2 * v2 + v3 * v3); }
                ss += __shfl_xor(ss, 16); ss += __shfl_xor(ss, 32);
                if (lane < 16) SSQ[(size_t)row * 16 + bx] = ss;
            }
            __syncthreads();
        }
        if (bx >= 16) {
            LAS float* scr = (LAS float*)(lds + RING_OFF + wave * 16384);
            constexpr int N_LATE = 2 * I_GU + I_DN + I_WO;
            const int lw = (bx - 16) * NWAVES + wave, nlw = (G - 16) * NWAVES;
            for (int l = lw; l < N_LATE; l += nlw) {
                const int it = l < 2 * I_GU ? I_POOL + 2 * I_GU + l : (l < 2 * I_GU + I_DN ? I_POOL + 4 * I_GU + I_DN + (l - 2 * I_GU) : I_POOL + 4 * I_GU + 2 * I_DN + I_QKV + (l - 2 * I_GU - I_DN));
                CONVERT_ITEM(it, scr);
            }
        }
    }
    { pg8::Gemm gn_{HB, Wqkv, MPAD, 3 * D, D, D, 0, MMAIN / 256}; pg8::StaticOrder Sn_; Sn_.init(MMAIN, 3 * D, G, bx);
      xcd_barrier_pf(bar, [&] { pg8::prefetch_b<pg8::EpiQKV, pg8::StaticOrder>(lds + RING_OFF, gn_, Sn_); }); }
    if (PHASE_MASK & (1 << 4))
    {
        pg8::Gemm g{HB, Wqkv, MPAD, 3 * D, D, D, 0, MMAIN / 256}; pg8::StaticOrder S; S.init(MMAIN, 3 * D, G, bx);
        pg8::EpiQKV E{QB_, QKV_STRIDE, SSQ, (unsigned*)(ctl + CW_KMAX), (LAS const unsigned char*)(lds + RING_OFF + pg8::SSQ_LDS)};
        for (int rep = 0; rep < REP_MISC; ++rep)
        pg8::gemm_phase<pg8::EpiQKV, pg8::StaticOrder, true, false, true>(lds + RING_OFF, g, S, E);
        if (bx < 3 * D / 16) {
            const int n0 = bx * 16; const int nrow[1] = {n0};
            f32x4 macc[1];
            if (mrow::partial_reduce<1, D / 256>(HB + (size_t)META0 * D, D, Wqkv, D, nrow, wave, lane, (LAS f32x4*)(lds + RING_OFF), macc)) {
                const int row = META0 + (lane & 15); const int t = n0 >> 10; const float rs = pg8::row_rstd(SSQ, row) * (t == 0 ? QSCALE : 1.0f);
                const f32x4 v = macc[0] * rs;
                *(u32x2*)(QB_ + (size_t)t * QKV_STRIDE + (size_t)row * D + (n0 & 1023) + 4 * (lane >> 4)) = (u32x2){cvtpk(v[0], v[1]), cvtpk(v[2], v[3])};
                if (t == 1) {
                    float mx = __builtin_fmaxf(__builtin_fmaxf(__builtin_fabsf(v[0]), __builtin_fabsf(v[1])), __builtin_fmaxf(__builtin_fabsf(v[2]), __builtin_fabsf(v[3])));
#pragma unroll
                    for (int o = 1; o < 64; o <<= 1) mx = __builtin_fmaxf(mx, __shfl_xor(mx, o));
                    if (lane == 0) atomicMax((unsigned*)(ctl + CW_KMAX) + 128 + ((n0 & 1023) >> 7) * 2 + ((n0 & 127) >> 6), __float_as_uint(mx));
                }
            }
            __syncthreads();
        }
    }
    xcd_barrier(bar);
    if (PHASE_MASK & (1 << 5))
    {
        float a1 = lq1[lane] * lk1[lane], a2 = lq2[lane] * lk2[lane];
        a1 = wave_sum(a1); a2 = wave_sum(a2);
        const float lam = __expf(a1) - __expf(a2) + LAMBDA_INIT;
        for (int rep = 0; rep < REP_P5; ++rep)
        for (int idx = vcu; idx < 2048; idx += G) {
            const int vv = idx & 255, i = idx >> 8, xg = vv >> 5, j = vv & 31, bh = xg * 8 + i, qb = (i & 1) ? 31 - j : j;
            att::attn_unit(bh >> 3, bh & 7, qb, QB_, KB_, VB_, OB_, lds + RING_OFF, rel_bias, subg, lam, (unsigned*)(ctl + CW_KMAX));
        }
    }
    { pg8::Gemm gn_{OB_, Wo, MMAIN, D, D, D, 0, MMAIN / 256}; pg8::StaticOrder Sn_; Sn_.init(MMAIN, D, G, bx);
      xcd_barrier_pf(bar, [&] { pg8::prefetch_b<pg8::EpiRes, pg8::StaticOrder>(lds + RING_OFF, gn_, Sn_); }); }
    if (PHASE_MASK & (1 << 6))
    {
        pg8::Gemm g{OB_, Wo, MMAIN, D, D, D, 0, MMAIN / 256}; pg8::StaticOrder S; S.init(MMAIN, D, G, bx);
        pg8::EpiRes E{nullptr, 0, nullptr, 0, HB, HB, SSQ};
        pg8::gemm_phase<pg8::EpiRes, pg8::StaticOrder, true, false, true>(lds + RING_OFF, g, S, E);
    }
    { pg8::Gemm gn_{HB, Wgu1, MMAIN, 2 * FF, D, D, 0, MMAIN / 256}; pg8::StaticOrder Sn_; Sn_.init(MMAIN, 2 * FF, G, bx);
      xcd_barrier_pf(bar, [&] { pg8::prefetch_b<pg8::EpiSwiGLU, pg8::StaticOrder>(lds + RING_OFF, gn_, Sn_); }); }
    if (PHASE_MASK & (1 << 7))
    {
        pg8::Gemm g{HB, Wgu1, MMAIN, 2 * FF, D, D, 0, MMAIN / 256}; pg8::StaticOrder S; S.init(MMAIN, 2 * FF, G, bx);
        pg8::EpiSwiGLU E{ACT, SSQ, (LAS const unsigned char*)(lds + RING_OFF + pg8::SSQ_LDS)};
        for (int rep = 0; rep < REP_GU; ++rep)
        pg8::gemm_phase<pg8::EpiSwiGLU, pg8::StaticOrder, true, false, true>(lds + RING_OFF, g, S, E);
    }
    { pg8::Gemm gn_{ACT, Wd1, MMAIN, D, FF, FF, 0, MMAIN / 256}; pg8::StaticOrder Sn_; Sn_.init(MMAIN, D, G, bx);
      xcd_barrier_pf(bar, [&] { pg8::prefetch_b<pg8::EpiRes, pg8::StaticOrder>(lds + RING_OFF, gn_, Sn_); }); }
    if (PHASE_MASK & (1 << 8))
    {
        pg8::Gemm g{ACT, Wd1, MMAIN, D, FF, FF, 0, MMAIN / 256}; pg8::StaticOrder S; S.init(MMAIN, D, G, bx);
        pg8::EpiRes E{nullptr, 0, nullptr, 0, HB, HB, SSQ};
        pg8::gemm_phase<pg8::EpiRes, pg8::StaticOrder, true, false, true>(lds + RING_OFF, g, S, E);
    }
    xcd_barrier(bar);
    if (PHASE_MASK & (1 << 9))
    {
        int lane9_ = (int)__builtin_amdgcn_mbcnt_hi(~0u, __builtin_amdgcn_mbcnt_lo(~0u, 0u)); asm volatile("" : "+v"(lane9_));
        const int lane = lane9_;
        f32x4 gv[4];
#pragma unroll
        for (int j = 0; j < 4; ++j) gv[j] = *((const f32x4*)fin_g + lane + 64 * j);
        const unsigned poison = xb_ld((unsigned*)(ctl + CW_BAR) + XB_TMO);
#define P9_LOAD(W, Q, r_) do { const int rr_ = (r_) < MMAIN ? (r_) : MMAIN - 1;     \
            const u32x2* hp_ = (const u32x2*)(HB + (size_t)rr_ * D) + lane; const f32x4* qp_ = (const f32x4*)(SSQ + (size_t)rr_ * 16); \
            _Pragma("unroll") for (int j = 0; j < 4; ++j) { W[j] = hp_[64 * j]; Q[j] = qp_[j]; } } while (0)
#define P9_FINISH(W, Q, r_) do { { \
            const float sq_ = ((Q[0][0] + Q[0][1]) + (Q[0][2] + Q[0][3])) + ((Q[1][0] + Q[1][1]) + (Q[1][2] + Q[1][3])) + ((Q[2][0] + Q[2][1]) + (Q[2][2] + Q[2][3])) + ((Q[3][0] + Q[3][1]) + (Q[3][2] + Q[3][3])); \
            float rs_ = __builtin_amdgcn_rsqf(sq_ * (1.0f / D) + RMS_EPS); if (poison) rs_ = __builtin_nanf(""); \
            f32x4* o_ = (f32x4*)(args.out + (size_t)(r_) * D) + lane; \
            _Pragma("unroll") for (int j = 0; j < 4; ++j) { const f32x4 v_ = {__uint_as_float(W[j][0] << 16), __uint_as_float(W[j][0] & 0xffff0000u), __uint_as_float(W[j][1] << 16), __uint_as_float(W[j][1] & 0xffff0000u)}; \
                o_[64 * j] = v_ * rs_ * gv[j]; } } } while (0)
        u32x2 wa[4], wb[4]; f32x4 qa[4], qb4[4];
#pragma unroll
        for (int j = 0; j < 4; ++j) { wa[j] = (u32x2){0u, 0u}; wb[j] = (u32x2){0u, 0u}; qa[j] = (f32x4){0.f, 0.f, 0.f, 0.f}; qb4[j] = (f32x4){0.f, 0.f, 0.f, 0.f}; }
        if (MMAIN % (2 * NGW) == 0) {
            P9_LOAD(wa, qa, gw);
            for (int r = gw; r < MMAIN; r += 2 * NGW) {
                P9_LOAD(wb, qb4, r + NGW);
                P9_FINISH(wa, qa, r);
                P9_LOAD(wa, qa, r + 2 * NGW);
                P9_FINISH(wb, qb4, r + NGW);
            }
        } else {
            for (int r = gw; r < MMAIN; r += NGW) { P9_LOAD(wa, qa, r); P9_FINISH(wa, qa, r); }
        }
#undef P9_LOAD
#undef P9_FINISH
    }
}

#undef CONVERT_ITEM
#undef x
#undef meta
#undef rel_bias
#undef mix_g
#undef ffn_g
#undef pool_w
#undef pool_scale
#undef w_qkv
#undef w_o
#undef lq1
#undef lk1
#undef lq2
#undef lk2
#undef subg
#undef w_gate
#undef w_up
#undef w_down
#undef fin_g
#undef Wpool
#undef Wgu0
#undef Wd0
#undef Wqkv
#undef Wo
#undef Wgu1
#undef Wd1
#undef SSQ
#undef H
#undef HB
#undef ACT
#undef QB_
#undef KB_
#undef VB_
#undef OB_

extern "C" void kernel_launch(void* const* d_in, const int* in_sizes, int n_in, void* d_out, int out_size, void* d_ws, size_t ws_size, hipStream_t stream) {
    static int grid = 0;
    if (grid == 0) {
        if (n_in != 18 || in_sizes[0] != MMAIN * D || out_size != MMAIN * D || ws_size < WS_END) {
            fprintf(stderr, "kernel_launch: unexpected shapes (n_in %d, in0 %d, out %d, ws %zu); nothing launched\n", n_in, n_in > 0 ? in_sizes[0] : -1, out_size, ws_size); grid = -1; return; }
        int dev = 0, cus = 0, per_cu = 0;
        if (hipGetDevice(&dev) != hipSuccess || hipDeviceGetAttribute(&cus, hipDeviceAttributeMultiprocessorCount, dev) != hipSuccess) { fprintf(stderr, "kernel_launch: device query failed\n"); grid = -1; return; }
        if (hipFuncSetAttribute((const void*)fwd_megakernel, hipFuncAttributeMaxDynamicSharedMemorySize, LDS_BYTES) != hipSuccess) { fprintf(stderr, "kernel_launch: hipFuncSetAttribute failed\n"); grid = -1; return; }
        if (hipOccupancyMaxActiveBlocksPerMultiprocessor(&per_cu, (const void*)fwd_megakernel, NWAVES * 64, LDS_BYTES) != hipSuccess || per_cu < 1) {
            fprintf(stderr, "kernel_launch: occupancy query reports %d workgroups per CU; nothing launched\n", per_cu); (void)hipGetLastError(); grid = -1; return; }
        grid = cus;
    }
    if (grid < 0) return;
    if (hipMemsetAsync((char*)d_ws + WS_CTL, 0, CTL_ZERO_BYTES, stream) != hipSuccess) { fprintf(stderr, "kernel_launch: hipMemsetAsync failed\n"); return; }
    Args a{};
    for (int i = 0; i < 18; ++i) a.in[i] = (const float*)d_in[i];
    a.out = (float*)d_out; a.ws = (unsigned char*)d_ws;
    hipLaunchKernelGGL(fwd_megakernel, dim3(grid), dim3(NWAVES * 64), LDS_BYTES, stream, a);
    const hipError_t le = hipPeekAtLastError();
    if (le != hipSuccess) fprintf(stderr, "kernel_launch: launch failed: %s\n", hipGetErrorName(le));
}
```

```cpp
#include <hip/hip_runtime.h>
#include <cstdio>
#include <cstdint>

#define LAS __attribute__((address_space(3)))
#define GAS __attribute__((address_space(1)))

typedef unsigned short bf16_t;
typedef short bf16x8 __attribute__((ext_vector_type(8)));
typedef short s16x4 __attribute__((ext_vector_type(4)));
typedef float f32x4 __attribute__((ext_vector_type(4)));
typedef float f32x2 __attribute__((ext_vector_type(2)));
typedef float f32x16 __attribute__((ext_vector_type(16)));
typedef unsigned u32x4 __attribute__((ext_vector_type(4)));
typedef unsigned u32x2 __attribute__((ext_vector_type(2)));
typedef __bf16 bf16x2_t __attribute__((ext_vector_type(2)));

constexpr int D = 1024, NB = 8, SEQ = 4096, NMETA = 16, FF = 2816, NH = 8;
constexpr int MMAIN = NB * SEQ;
constexpr int META0 = MMAIN;
constexpr int MPAD = MMAIN + 256;
constexpr float RMS_EPS = 1e-6f;
constexpr float LOG2E = 1.4426950408889634f;
constexpr float QSCALE = 0.125f * LOG2E;
constexpr float LAMBDA_INIT = 0.35550906759096926f;

__device__ __forceinline__ unsigned cvtpk(float lo, float hi) { f32x2 v = {lo, hi}; bf16x2_t b = __builtin_convertvector(v, bf16x2_t); return __builtin_bit_cast(unsigned, b); }
__device__ __forceinline__ float wave_sum(float v) {
#pragma unroll
    for (int o = 1; o < 64; o <<= 1) v += __shfl_xor(v, o);
    return v;
}

namespace pg8 {
constexpr int SSQ_LDS = 131072 + 8192;
constexpr int BM = 256, BK = 64, HALF = 128, HTB = HALF * BK * 2, STAGE_BYTES = 8 * HTB, NXCD = 8, WGM = 4;
__host__ __device__ __forceinline__ int lds_byte(int r, int c) { const int st = (r >> 4) * 2 + (c >> 5), rr = r & 15, cc = c & 31, ob = rr * 64 + cc * 2; return st * 1024 + (ob ^ (((ob >> 9) & 1) << 5)); }
__host__ __device__ __forceinline__ void stage_rc(int b, int& R, int& C) { const int st = b / 1024, sb = b % 1024, swz = sb ^ (((sb >> 9) & 1) << 5); R = (st >> 1) * 16 + swz / 64; C = (st & 1) * 32 + (swz % 64) / 2; }
__host__ __device__ __forceinline__ int perm32(int rho) { const int n = rho >> 4, i = rho & 15; return 8 * (i >> 2) + 4 * n + (i & 3); }

struct Unit { int pm, pn; };
struct Gemm { const bf16_t* A; const bf16_t* Bt; int M, N, K; int lda; int a_pn_off; int m_full; };

struct StaticOrder {
    int nM, nN, nwg, G, c;
    __device__ void init(int M, int N, int G_, int c_) { nM = M / BM; nN = N / BM; nwg = nM * nN; G = G_; c = c_; }
    __device__ bool next(int i, Unit& u) const {
        const long L = (long)i * G + c; if (L >= nwg) return false;
        int wgid = (int)L; { const int q = nwg / NXCD, r = nwg % NXCD, xcd = wgid % NXCD, off = wgid / NXCD; wgid = (xcd < r ? xcd * (q + 1) : r * (q + 1) + (xcd - r) * q) + off; }
        const int nig = WGM * nN, gid = wgid / nig, fm = gid * WGM, gsz = (nM - fm) < WGM ? (nM - fm) : WGM;
        u.pm = fm + ((wgid % nig) % gsz); u.pn = (wgid % nig) / gsz; return true;
    }
};

struct MetaOrder {
    int pm, nN, c;
    __device__ bool next(int i, Unit& u) const { if (i > 0 || c >= nN) return false; u.pm = pm; u.pn = c; return true; }
};

__device__ __forceinline__ float row_rstd(const float* ssq, int row) {
    const f32x4* p = (const f32x4*)(ssq + (size_t)row * 16);
    const f32x4 a = p[0], b = p[1], c = p[2], d = p[3];
    const float s = ((a[0] + a[1]) + (a[2] + a[3])) + ((b[0] + b[1]) + (b[2] + b[3])) + ((c[0] + c[1]) + (c[2] + c[3])) + ((d[0] + d[1]) + (d[2] + d[3]));
    return __builtin_amdgcn_rsqf(s * (1.0f / D) + RMS_EPS);
}

__device__ __forceinline__ float row_rstd_lds(LAS const unsigned char* blk, int r) {
    const LAS f32x4* p = (const LAS f32x4*)(blk + r * 64);
    const f32x4 a = p[0], b = p[1], c = p[2], d = p[3];
    const float s = ((a[0] + a[1]) + (a[2] + a[3])) + ((b[0] + b[1]) + (b[2] + b[3])) + ((c[0] + c[1]) + (c[2] + c[3])) + ((d[0] + d[1]) + (d[2] + d[3]));
    return __builtin_amdgcn_rsqf(s * (1.0f / D) + RMS_EPS);
}

struct EpiRes {
    static constexpr bool PERM = true; static constexpr bool RSTD_LDS = false; static constexpr int NSTORES = 16;
    const float* r_main; int n_main; const float* r_aux; int n_aux;
    const bf16_t* r_bf;
    bf16_t* Hb; float* ssq;
    __device__ __forceinline__ void finish(const f32x4 (&acc)[2][2][4][2], int ai, int m, int bj, int row, int col, const f32x4& r0, const f32x4& r1, float& s) const {
        const f32x4 v0 = acc[ai][bj][m][0] + r0, v1 = acc[ai][bj][m][1] + r1;
        u32x4 w; w[0] = cvtpk(v0[0], v0[1]); w[1] = cvtpk(v0[2], v0[3]); w[2] = cvtpk(v1[0], v1[1]); w[3] = cvtpk(v1[2], v1[3]);
        *(u32x4*)(Hb + (size_t)row * D + col) = w;
        s += (v0[0] * v0[0] + v0[1] * v0[1]) + (v0[2] * v0[2] + v0[3] * v0[3]) + (v1[0] * v1[0] + v1[1] * v1[1]) + (v1[2] * v1[2] + v1[3] * v1[3]);
    }
    __device__ __forceinline__ void operator()(const f32x4 (&acc)[2][2][4][2], const Unit& u, int wr, int wc, int fr, int fq) const {
        const int col0 = u.pn * BM + wc * 32 + 8 * fq;
        const int row0 = u.pm * BM + wr * 64 + fr;
        if (r_bf) {
            u32x4 rb[2][4][2];
#pragma unroll
            for (int ai = 0; ai < 2; ++ai)
#pragma unroll
                for (int m = 0; m < 4; ++m)
#pragma unroll
                    for (int bj = 0; bj < 2; ++bj) rb[ai][m][bj] = *(const u32x4*)(r_bf + (size_t)(row0 + ai * HALF + m * 16) * D + col0 + bj * HALF);
#pragma unroll
            for (int ai = 0; ai < 2; ++ai)
#pragma unroll
                for (int m = 0; m < 4; ++m) {
                    const int row = row0 + ai * HALF + m * 16;
                    float s = 0.f;
#pragma unroll
                    for (int bj = 0; bj < 2; ++bj) { const u32x4 q = rb[ai][m][bj];
                        const f32x4 r0 = {__uint_as_float(q[0] << 16), __uint_as_float(q[0] & 0xffff0000u), __uint_as_float(q[1] << 16), __uint_as_float(q[1] & 0xffff0000u)};
                        const f32x4 r1 = {__uint_as_float(q[2] << 16), __uint_as_float(q[2] & 0xffff0000u), __uint_as_float(q[3] << 16), __uint_as_float(q[3] & 0xffff0000u)};
                        finish(acc, ai, m, bj, row, col0 + bj * HALF, r0, r1, s); }
                    s += __shfl_xor(s, 16); s += __shfl_xor(s, 32);
                    if (fq == 0) ssq[(size_t)row * 16 + u.pn * 4 + wc] = s;
                }
        } else {
#pragma unroll
            for (int ai = 0; ai < 2; ++ai) {
                f32x4 rf[4][2][2];
#pragma unroll
                for (int m = 0; m < 4; ++m) {
                    const int row = row0 + ai * HALF + m * 16;
                    const float* rp = row < n_main ? r_main + (size_t)row * D : ((row - n_main) < n_aux ? r_aux + (size_t)(row - n_main) * D : nullptr);
#pragma unroll
                    for (int bj = 0; bj < 2; ++bj) { rf[m][bj][0] = (f32x4){0.f, 0.f, 0.f, 0.f}; rf[m][bj][1] = (f32x4){0.f, 0.f, 0.f, 0.f};
                        if (rp) { rf[m][bj][0] = *(const f32x4*)(rp + col0 + bj * HALF); rf[m][bj][1] = *(const f32x4*)(rp + col0 + bj * HALF + 4); } }
                }
#pragma unroll
                for (int m = 0; m < 4; ++m) {
                    const int row = row0 + ai * HALF + m * 16;
                    float s = 0.f;
#pragma unroll
                    for (int bj = 0; bj < 2; ++bj) finish(acc, ai, m, bj, row, col0 + bj * HALF, rf[m][bj][0], rf[m][bj][1], s);
                    s += __shfl_xor(s, 16); s += __shfl_xor(s, 32);
                    if (fq == 0) ssq[(size_t)row * 16 + u.pn * 4 + wc] = s;
                }
            }
        }
    }
};

struct EpiSwiGLU {
    static constexpr bool PERM = true; static constexpr bool RSTD_LDS = true; static constexpr int NSTORES = 8;
    bf16_t* ACT; const float* ssq; LAS const unsigned char* blk;
    __device__ __forceinline__ void operator()(const f32x4 (&acc)[2][2][4][2], const Unit& u, int wr, int wc, int fr, int fq) const {
        const int col0 = u.pn * HALF + wc * 32 + 8 * fq;
        const int ln = fq * 16 + fr;
        const float rsA = row_rstd_lds(blk, wr * 64 + ln), rsB = row_rstd_lds(blk, HALF + wr * 64 + ln);
#pragma unroll
        for (int ai = 0; ai < 2; ++ai)
#pragma unroll
            for (int m = 0; m < 4; ++m) {
                const int row = u.pm * BM + ai * HALF + wr * 64 + m * 16 + fr;
                const float rs = __shfl(ai ? rsB : rsA, m * 16 + fr);
                float o[8];
#pragma unroll
                for (int n = 0; n < 2; ++n)
#pragma unroll
                    for (int e = 0; e < 4; ++e) {
                        const float g = acc[ai][0][m][n][e] * rs, up = acc[ai][1][m][n][e] * rs;
                        const float sg = __builtin_amdgcn_rcpf(1.0f + __builtin_amdgcn_exp2f(-g * LOG2E));
                        o[n * 4 + e] = g * sg * up;
                    }
                u32x4 w; w.x = cvtpk(o[0], o[1]); w.y = cvtpk(o[2], o[3]); w.z = cvtpk(o[4], o[5]); w.w = cvtpk(o[6], o[7]);
                *(u32x4*)(ACT + (size_t)row * FF + col0) = w;
            }
    }
};

struct EpiQKV {
    static constexpr bool PERM = true; static constexpr bool RSTD_LDS = true; static constexpr int NSTORES = 16;
    bf16_t* Q; size_t tstride; const float* ssq; unsigned* kmax; LAS const unsigned char* blk;
    __device__ __forceinline__ void operator()(const f32x4 (&acc)[2][2][4][2], const Unit& u, int wr, int wc, int fr, int fq) const {
        float kx0 = 0.f, kx1 = 0.f;
        const int t = u.pn >> 2; bf16_t* base = Q + (size_t)t * tstride; const float sc = (t == 0) ? QSCALE : 1.0f;
        const int col0 = (u.pn & 3) * BM + wc * 32 + 8 * fq;
        const int ln = fq * 16 + fr;
        const float rsA = row_rstd_lds(blk, wr * 64 + ln), rsB = row_rstd_lds(blk, HALF + wr * 64 + ln);
#pragma unroll
        for (int ai = 0; ai < 2; ++ai)
#pragma unroll
            for (int m = 0; m < 4; ++m) {
                const int row = u.pm * BM + ai * HALF + wr * 64 + m * 16 + fr;
                const float rs = __shfl(ai ? rsB : rsA, m * 16 + fr) * sc;
#pragma unroll
                for (int bj = 0; bj < 2; ++bj) {
                    const f32x4 v0 = acc[ai][bj][m][0] * rs, v1 = acc[ai][bj][m][1] * rs;
                    u32x4 w; w.x = cvtpk(v0[0], v0[1]); w.y = cvtpk(v0[2], v0[3]); w.z = cvtpk(v1[0], v1[1]); w.w = cvtpk(v1[2], v1[3]);
                    *(u32x4*)(base + (size_t)row * D + col0 + bj * HALF) = w;
                    if (t == 1) { const float mx = __builtin_fmaxf(__builtin_fmaxf(__builtin_fmaxf(__builtin_fabsf(v0[0]), __builtin_fabsf(v0[1])), __builtin_fmaxf(__builtin_fabsf(v0[2]), __builtin_fabsf(v0[3]))),
                                                              __builtin_fmaxf(__builtin_fmaxf(__builtin_fabsf(v1[0]), __builtin_fabsf(v1[1])), __builtin_fmaxf(__builtin_fabsf(v1[2]), __builtin_fabsf(v1[3]))));
                        if (bj == 0) kx0 = __builtin_fmaxf(kx0, mx); else kx1 = __builtin_fmaxf(kx1, mx); }
                }
            }
        if (t == 1) {
#pragma unroll
            for (int o = 1; o < 64; o <<= 1) { kx0 = __builtin_fmaxf(kx0, __shfl_xor(kx0, o)); kx1 = __builtin_fmaxf(kx1, __shfl_xor(kx1, o)); }
            if (fr == 0 && fq == 0) { unsigned* kp = kmax + (((u.pm >> 4) * 8 + (u.pn & 3) * 2) * 2 + (wc >> 1));
                atomicMax(kp, __float_as_uint(kx0)); atomicMax(kp + 2, __float_as_uint(kx1)); }
        }
    }
};

template <class Epi, class Sched, bool ALIGN_EPI, bool SHORT = false, bool BPRE = false>
__device__ __forceinline__ void gemm_phase(LAS unsigned char* lds, const Gemm g, const Sched& S, const Epi& E) {
    int tid_ = threadIdx.x; asm volatile("" : "+v"(tid_));
    const int tid = tid_, wid = __builtin_amdgcn_readfirstlane(tid >> 6), lane = tid & 63, wr = wid >> 2, wc = wid & 3, fr = lane & 15, fq = lane >> 4;
    const int K = g.K, nt = K / BK, lda = g.lda;
    unsigned voffA[2], voffB[2];
#pragma unroll
    for (int i = 0; i < 2; ++i) { int R, C; stage_rc(tid * 16 + i * 8192, R, C); const int Rb = Epi::PERM ? ((R & ~31) + perm32(R & 31)) : R;
        voffA[i] = (unsigned)((SHORT ? (R & 15) : R) * lda + C) * 2u; voffB[i] = (unsigned)(Rb * K + C) * 2u; }
    const size_t kstep = (size_t)(BK * 2);
    const size_t tstepA = (size_t)BM * lda * 2, hstepA = SHORT ? 0 : (size_t)HALF * lda * 2;
    const size_t hstepB = (size_t)HALF * K * 2, tstepB = 2 * hstepB;
    const size_t pnoffA = (size_t)g.a_pn_off * 2;
    const unsigned ldsdst = (unsigned)__builtin_amdgcn_readfirstlane((int)((unsigned)(uintptr_t)lds + (unsigned)wid * 1024u));
    const unsigned ldsssq = (unsigned)__builtin_amdgcn_readfirstlane((int)((unsigned)(uintptr_t)lds + (unsigned)SSQ_LDS + (unsigned)wid * 2048u));
    const int aoff = lds_byte(wr * 64 + fr, fq * 8), boff = lds_byte(wc * 32 + fr, fq * 8);
#define PG8_SA(b, h) (((b) * 2 + (h)) * HTB)
#define PG8_SB(b, h) ((4 + (b) * 2 + (h)) * HTB)
#define PG8_STAGE(bufoff, gbase, voff) do { _Pragma("unroll") for (int _i = 0; _i < 2; ++_i) \
        asm volatile("s_mov_b32 m0, %2\n\ts_nop 0\n\tglobal_load_lds_dwordx4 %0, %1" :: "v"((voff)[_i]), "s"((const char*)(gbase)), "s"(ldsdst + (unsigned)((bufoff) + _i * 8192)) : "memory"); } while (0)
#define PG8_LDA(dst, b, h) do { _Pragma("unroll") for (int m = 0; m < 4; ++m) _Pragma("unroll") for (int k = 0; k < 2; ++k) dst[m][k] = *(const LAS bf16x8*)(lds + PG8_SA(b, h) + aoff + m * 2048 + k * 1024); } while (0)
#define PG8_LDB(dst, b, h) do { _Pragma("unroll") for (int n = 0; n < 2; ++n) _Pragma("unroll") for (int k = 0; k < 2; ++k) dst[n][k] = *(const LAS bf16x8*)(lds + PG8_SB(b, h) + boff + n * 2048 + k * 1024); } while (0)
#define PG8_MMA(ai, bj, At, Bt) do { if constexpr (!SHORT) { __builtin_amdgcn_s_setprio(1); _Pragma("unroll") for (int m = 0; m < 4; ++m) _Pragma("unroll") for (int n = 0; n < 2; ++n) _Pragma("unroll") for (int k = 0; k < 2; ++k) \
        acc[ai][bj][m][n] = __builtin_amdgcn_mfma_f32_16x16x32_bf16(Bt[n][k], At[m][k], acc[ai][bj][m][n], 0, 0, 0); __builtin_amdgcn_s_setprio(0); } \
      else if ((ai) == 0) { if (wr == 0) { _Pragma("unroll") for (int n = 0; n < 2; ++n) _Pragma("unroll") for (int k = 0; k < 2; ++k) \
        acc[0][bj][0][n] = __builtin_amdgcn_mfma_f32_16x16x32_bf16(Bt[n][k], At[0][k], acc[0][bj][0][n], 0, 0, 0); } } } while (0)
#define PG8_WAIT_V(n) asm volatile("s_waitcnt vmcnt(" #n ")" ::: "memory")
#define PG8_WAIT_VN(n) asm volatile("s_waitcnt vmcnt(%0)" :: "n"(n) : "memory")
#define PG8_WAIT_L(n) asm volatile("s_waitcnt lgkmcnt(" #n ")" ::: "memory")
#define PG8_BAR __builtin_amdgcn_s_barrier()
#define PG8_SCHED __builtin_amdgcn_sched_barrier(0)
    Unit cur, nxt; int ui = 0;
    if (!S.next(0, cur)) return;
    f32x4 acc[2][2][4][2];
#pragma unroll
    for (int a = 0; a < 2; ++a)
#pragma unroll
        for (int b = 0; b < 2; ++b)
#pragma unroll
            for (int m = 0; m < 4; ++m)
#pragma unroll
                for (int n = 0; n < 2; ++n) acc[a][b][m][n] = (f32x4){0.f, 0.f, 0.f, 0.f};
    bf16x8 At[4][2], B0[2][2], B1[2][2];
    const char* cA = (const char*)g.A + (size_t)cur.pm * tstepA + (size_t)cur.pn * pnoffA; const char* cB = (const char*)g.Bt + (size_t)cur.pn * tstepB;
    if constexpr (!BPRE) { PG8_STAGE(PG8_SB(0, 0), cB, voffB); PG8_STAGE(PG8_SB(0, 1), cB + hstepB, voffB); } PG8_STAGE(PG8_SA(0, 0), cA, voffA); PG8_STAGE(PG8_SA(0, 1), cA + hstepA, voffA);
    if constexpr (BPRE) {
        PG8_STAGE(PG8_SA(1, 0), cA + kstep, voffA); PG8_STAGE(PG8_SA(1, 1), cA + kstep + hstepA, voffA);
        if (wr == 1) PG8_BAR;
        PG8_WAIT_V(0); PG8_BAR;
        PG8_BAR;
    } else {
    if (wr == 1) PG8_BAR;
    PG8_WAIT_V(2); PG8_BAR;
    PG8_STAGE(PG8_SB(1, 0), cB + kstep, voffB); PG8_STAGE(PG8_SA(1, 0), cA + kstep, voffA); PG8_STAGE(PG8_SB(1, 1), cB + hstepB + kstep, voffB);
    if constexpr (!SHORT) PG8_STAGE(PG8_SA(1, 1), cA + kstep + hstepA, voffA);
    if constexpr (SHORT) PG8_WAIT_V(6); else PG8_WAIT_V(0);
    PG8_BAR;
    }
    for (;;) {
        const bool has_next = S.next(ui + 1, nxt);
        const char* nA = has_next ? (const char*)g.A + (size_t)nxt.pm * tstepA + (size_t)nxt.pn * pnoffA : cA; const char* nB = has_next ? (const char*)g.Bt + (size_t)nxt.pn * tstepB : cB;
#define PG8_SSQ(ON) do { if constexpr (Epi::RSTD_LDS && !SHORT) { if (ON) { const char* sb_ = (const char*)(E.ssq + (size_t)cur.pm * (BM * 16)); \
            _Pragma("unroll") for (int _i = 0; _i < 2; ++_i) asm volatile("s_mov_b32 m0, %2\n\ts_nop 0\n\tglobal_load_lds_dwordx4 %0, %1" :: "v"((unsigned)(wid * 2048 + _i * 1024 + lane * 16)), "s"(sb_), "s"(ldsssq + (unsigned)(_i * 1024)) : "memory"); } } } while (0)
#define PG8_ITER(W1, W2, W3, W4, STG11) do { \
            const bool last = (t == nt - 2); \
            const char* a1 = cA + (size_t)(t + 1) * kstep; \
            const char* a2 = last ? nA : cA + (size_t)(t + 2) * kstep; const char* b2 = last ? nB : cB + (size_t)(t + 2) * kstep; \
            const char* a3 = a2 + kstep; const char* b3 = b2 + kstep; \
              \
            PG8_LDB(B0, 0, 0); PG8_LDB(B1, 0, 1); PG8_SCHED; PG8_LDA(At, 0, 0); if (STG11) PG8_STAGE(PG8_SA(1, 1), a1 + hstepA, voffA); \
            PG8_WAIT_VN(W1); PG8_WAIT_L(0); PG8_BAR; PG8_MMA(0, 0, At, B0); PG8_MMA(0, 1, At, B1); PG8_BAR; PG8_SCHED; \
              \
            PG8_LDA(At, 0, 1); PG8_STAGE(PG8_SB(0, 0), b2, voffB); PG8_STAGE(PG8_SB(0, 1), b2 + hstepB, voffB); PG8_STAGE(PG8_SA(0, 0), a2, voffA); PG8_SSQ(!(STG11)); \
            PG8_WAIT_VN(W2); PG8_WAIT_L(0); PG8_BAR; PG8_MMA(1, 0, At, B0); PG8_MMA(1, 1, At, B1); PG8_BAR; PG8_SCHED; \
              \
            PG8_LDB(B0, 1, 0); PG8_LDB(B1, 1, 1); PG8_SCHED; PG8_LDA(At, 1, 0); PG8_STAGE(PG8_SA(0, 1), a2 + hstepA, voffA); \
            PG8_WAIT_VN(W3); PG8_WAIT_L(0); PG8_BAR; PG8_MMA(0, 0, At, B0); PG8_MMA(0, 1, At, B1); PG8_BAR; PG8_SCHED; \
              \
            PG8_LDA(At, 1, 1); PG8_STAGE(PG8_SB(1, 0), b3, voffB); PG8_STAGE(PG8_SB(1, 1), b3 + hstepB, voffB); PG8_STAGE(PG8_SA(1, 0), a3, voffA); \
            PG8_WAIT_VN(W4); PG8_WAIT_L(0); PG8_BAR; PG8_MMA(1, 0, At, B0); PG8_MMA(1, 1, At, B1); PG8_BAR; PG8_SCHED; } while (0)
        if constexpr (!SHORT) { { const int t = 0; constexpr int X = (Epi::RSTD_LDS ? 2 : 0);
              PG8_ITER(Epi::NSTORES + 2, Epi::NSTORES + 8 + X, Epi::NSTORES + 10 + X, Epi::NSTORES + 14 + X, false); }
            for (int t = 2; t < nt; t += 2) PG8_ITER(8, 8, 8, 8, true);
            PG8_STAGE(PG8_SA(1, 1), nA + kstep + hstepA, voffA); }
        else { for (int t = 0; t < nt; t += 2) PG8_ITER(8, 8, 8, 8, true); }
#undef PG8_ITER
#undef PG8_SSQ
        if constexpr (ALIGN_EPI) { if (wr == 0) PG8_BAR; }
        E(acc, cur, wr, wc, fr, fq);
        if (!has_next) break;
#pragma unroll
        for (int a = 0; a < 2; ++a)
#pragma unroll
            for (int b = 0; b < 2; ++b)
#pragma unroll
                for (int m = 0; m < 4; ++m)
#pragma unroll
                    for (int n = 0; n < 2; ++n) acc[a][b][m][n] = (f32x4){0.f, 0.f, 0.f, 0.f};
        cur = nxt; cA = nA; cB = nB; ++ui;
        if constexpr (ALIGN_EPI) { if (wr == 1) PG8_BAR; }
    }
    PG8_WAIT_V(0);
    if constexpr (!ALIGN_EPI) { if (wr == 0) PG8_BAR; }
    PG8_BAR;
#undef PG8_SA
#undef PG8_SB
#undef PG8_STAGE
#undef PG8_LDA
#undef PG8_LDB
#undef PG8_MMA
#undef PG8_WAIT_V
#undef PG8_WAIT_VN
#undef PG8_WAIT_L
#undef PG8_BAR
#undef PG8_SCHED
}
template <class Epi, class Sched>
__device__ __forceinline__ void prefetch_b(LAS unsigned char* lds, const Gemm g, const Sched& S) {
    int tid_ = threadIdx.x; asm volatile("" : "+v"(tid_));
    const int tid = tid_, wid = __builtin_amdgcn_readfirstlane(tid >> 6);
    Unit u; if (!S.next(0, u)) return;
    const int K = g.K;
    const size_t hstepB = (size_t)HALF * K * 2, kstep = (size_t)(BK * 2);
    const char* cB = (const char*)g.Bt + (size_t)u.pn * (2 * hstepB);
    const unsigned ldsdst = (unsigned)__builtin_amdgcn_readfirstlane((int)((unsigned)(uintptr_t)lds + (unsigned)wid * 1024u));
#pragma unroll
    for (int i = 0; i < 2; ++i) { int R, C; stage_rc(tid * 16 + i * 8192, R, C); const int Rb = Epi::PERM ? ((R & ~31) + perm32(R & 31)) : R;
        const unsigned vo = (unsigned)(Rb * K + C) * 2u;
#pragma unroll
        for (int q = 0; q < 4; ++q) {
            const char* src = cB + (q & 1) * hstepB + (q >> 1) * kstep;
            asm volatile("s_mov_b32 m0, %2\n\ts_nop 0\n\tglobal_load_lds_dwordx4 %0, %1" :: "v"(vo), "s"(src), "s"(ldsdst + (unsigned)((4 + (q >> 1) * 2 + (q & 1)) * HTB + i * 8192)) : "memory"); } }
}
}

namespace att {
typedef LAS const char* lds_cptr;
typedef short v4i16_t __attribute__((ext_vector_type(4)));
constexpr int PITCH = 1024, QB = 128, KVB = 64;
constexpr int KSLOT = 16384, VSLOT = 16384;
constexpr int LDS_V = 3 * KSLOT;
constexpr int LDS_TAB = LDS_V + 3 * VSLOT;
constexpr int LDS_WSF = LDS_TAB + 1152;
constexpr int THR = 8, FIXTHR = 80;
__device__ __forceinline__ int crow(int r, int hi) { return (r & 3) + 8 * (r >> 2) + 4 * hi; }
__device__ __forceinline__ void glds16(const void* gsrc, unsigned lds_dst) { unsigned keep;
    asm volatile("s_mov_b32 %0, m0\n\ts_mov_b32 m0, %2\n\ts_nop 0\n\tglobal_load_lds_dwordx4 %1, off\n\ts_mov_b32 m0, %0" : "=&s"(keep) : "v"(gsrc), "s"(lds_dst) : "memory"); }
__device__ __forceinline__ s16x4 vtr(lds_cptr p) { return __builtin_bit_cast(s16x4, __builtin_amdgcn_ds_read_tr16_b64_v4i16((LAS v4i16_t*)p)); }
#define ATT_WAIT_BAR() asm volatile("s_waitcnt vmcnt(0) lgkmcnt(0)\n\ts_barrier" ::: "memory")
#define ATT_LBAR() asm volatile("s_waitcnt lgkmcnt(0)\n\ts_barrier" ::: "memory")
#define MX3(a, b, c) __builtin_fmaxf(__builtin_fmaxf((a), (b)), (c))
__device__ __forceinline__ float rowmax(const f32x16& p0, const f32x16& p1) {
    float a = MX3(p0[0], p0[1], p1[0]), b = MX3(p0[2], p0[3], p1[1]); a = MX3(a, p1[2], p1[3]);
#pragma unroll
    for (int r = 4; r < 16; r += 4) { a = MX3(a, p0[r], p0[r + 1]); b = MX3(b, p0[r + 2], p0[r + 3]); a = MX3(a, p1[r], p1[r + 1]); b = MX3(b, p1[r + 2], p1[r + 3]); }
    const float m = __builtin_fmaxf(a, b); auto rr = __builtin_amdgcn_permlane32_swap(__float_as_uint(m), __float_as_uint(m), false, false);
    return __builtin_fmaxf(__uint_as_float(rr[0]), __uint_as_float(rr[1]));
}
__device__ __forceinline__ int t5_bucket(int rel) {
    if (rel < 16) return rel;
    int b = 16;
    b += rel >= 19; b += rel >= 21; b += rel >= 24; b += rel >= 27; b += rel >= 31; b += rel >= 35; b += rel >= 40; b += rel >= 46;
    b += rel >= 52; b += rel >= 59; b += rel >= 67; b += rel >= 77; b += rel >= 87; b += rel >= 99; b += rel >= 113;
    return b;
}

__device__ __forceinline__ void attn_unit(int b, int h, int qb, const bf16_t* Q, const bf16_t* K, const bf16_t* V, bf16_t* O, LAS unsigned char* shm,
                                          const float* rel_bias, const float* subg, float lam, unsigned* kmax) {
    int tid_ = threadIdx.x; asm volatile("" : "+v"(tid_));
    const int tid = tid_, lane = tid & 63, r32 = lane & 31, hi = lane >> 5; const int wid = __builtin_amdgcn_readfirstlane(tid >> 6);
    const int mp = wid >> 2, wq = wid & 3;
    const int q0 = qb * QB, qw0 = q0 + 32 * wq;
    const long rowb = (long)b * SEQ;
    const unsigned lds0 = (unsigned)(uintptr_t)shm;
    LAS float* wsf = (LAS float*)(shm + LDS_WSF) + wid * 64;
    LAS float* tab = (LAS float*)(shm + LDS_TAB);
    const float cb = rel_bias[31 * NH + h] * LOG2E;
    if (tid < 288) { const int rel = tid - 64; tab[tid] = rel < 0 ? -INFINITY : (rel < 128 ? (rel_bias[t5_bucket(rel) * NH + h] - rel_bias[31 * NH + h]) * LOG2E : 0.f); }
#define ATT_ISSUE_K(t, koff) do { \
        const long krow_ = ((t) == 0) ? (long)META0 : rowb + 64 * ((t) - 1); \
        const bf16_t* ks_ = K + (krow_ + lane) * PITCH + h * 128 + wid * 8; \
        glds16(ks_, (unsigned)__builtin_amdgcn_readfirstlane(lds0 + (koff) + wid * 1024)); \
        glds16(ks_ + 64, (unsigned)__builtin_amdgcn_readfirstlane(lds0 + (koff) + 8192 + wid * 1024)); } while (0)
#define ATT_ISSUE_V(t, voff) do { \
        const long vrow_ = ((t) == 0) ? (long)META0 : rowb + 64 * ((t) - 1); \
        const bf16_t* vs_ = V + (vrow_ + 16 * (wid & 3) + (lane >> 2)) * PITCH + h * 128 + 32 * (wid >> 2) + (lane & 3) * 8; \
        glds16(vs_, (unsigned)__builtin_amdgcn_readfirstlane(lds0 + LDS_V + (voff) + wid * 1024)); \
        glds16(vs_ + 64, (unsigned)__builtin_amdgcn_readfirstlane(lds0 + LDS_V + (voff) + 8192 + wid * 1024)); } while (0)
    const int NT = 1 + 2 * (qb + 1);
    ATT_ISSUE_K(0, 0); ATT_ISSUE_V(0, 0); ATT_ISSUE_K(1, KSLOT); ATT_ISSUE_V(1, VSLOT); ATT_ISSUE_K(2, 2 * KSLOT);
    bf16x8 qr[4];
    { const bf16_t* Qw = Q + (rowb + qw0 + r32) * PITCH + h * 128 + mp * 64 + hi * 8;
#pragma unroll
      for (int d0 = 0; d0 < 4; ++d0) qr[d0] = *(const bf16x8*)(Qw + d0 * 16); }
    const unsigned kmx_a = __hip_atomic_load(kmax + (b * 8 + h) * 2 + mp, __ATOMIC_RELAXED, __HIP_MEMORY_SCOPE_AGENT), kmx_b = __hip_atomic_load(kmax + 128 + h * 2 + mp, __ATOMIC_RELAXED, __HIP_MEMORY_SCOPE_AGENT);
    const float bv_raw = rel_bias[(lane & 31) * NH + h];
    float mhat = 0.f, l_reg = 0.f;
    f32x16 o[4];
#pragma unroll
    for (int vb = 0; vb < 4; ++vb) o[vb] = f32x16{};
    f32x16 cinit;
#pragma unroll
    for (int r = 0; r < 16; ++r) cinit[r] = cb;
    const lds_cptr shm3 = (lds_cptr)shm;
    const lds_cptr kp0 = shm3 + mp * 8192 + hi * 1024 + r32 * 16;
    const lds_cptr vp0 = shm3 + LDS_V + ((lane >> 4) & 1) * 32 + (lane & 3) * 8 + (4 * hi + ((lane & 15) >> 2)) * 64;
#define SBAR() __builtin_amdgcn_sched_barrier(0)
#define PIN(x) asm volatile("" : "+v"(x))
#define MFMA(a, b, c) __builtin_amdgcn_mfma_f32_32x32x16_bf16(a, b, c, 0, 0, 0)
#define KFR(j) (*(const LAS bf16x8*)(kp_ + ((j) >> 1) * 2048 + ((j) & 1) * 512))
#define KRD(F, j) do { if (F) kf##j = KFR(j); } while (0)
#define PKW(P, B) cvtpk(P[B], P[(B) + 1])
#define EX(v) __builtin_amdgcn_exp2f(v)
#define VRD(dst, h) do { dst[0] = vtr(vp_ + ((h) >> 2) * 4096 + ((h) & 3) * 1024); dst[1] = vtr(vp_ + ((h) >> 2) * 4096 + ((h) & 3) * 1024 + 512); } while (0)
#define VFRAG(src) ((bf16x8){src[0][0], src[0][1], src[0][2], src[0][3], src[1][0], src[1][1], src[1][2], src[1][3]})
#define PAF(k) __builtin_bit_cast(bf16x8, pw##k)
#define GAPA(MF, A0, A1, A2, A3, W0, W1, PW) do { MF; sacc += A0; sacc += A1; sacc += A2; sacc += A3; PIN(sacc); W0; W1; PIN(PW); SBAR(); } while (0)
#define GAPB(VR, KR, MF, X, B) do { VR; KR; MF; X[B] = EX(X[B]); X[(B) + 1] = EX(X[(B) + 1]); PIN(X); SBAR(); } while (0)
#define GAPB0(VR, KR, MF) do { VR; KR; MF; SBAR(); } while (0)
    u32x4 pw0, pw1, pw2, pw3;
    bf16x8 kf0, kf1, kf2, kf3, kf4, kf5, kf6, kf7;
    bool resc = false;
#define PHASE_A(C0, C1, P0, P1, t, DOQK) do { SBAR(); float sacc = P0[0] + P0[1]; \
        if (DOQK) { \
            GAPA(C0 = MFMA(kf0, qr[0], cinit), P0[2], P0[3], P0[4], P0[5],     pw0[0] = PKW(P0, 0),  pw0[1] = PKW(P0, 2),  pw0); \
            GAPA(C1 = MFMA(kf1, qr[0], cinit), P0[6], P0[7], P0[8], P0[9],     pw0[2] = PKW(P0, 4),  pw0[3] = PKW(P0, 6),  pw0); \
            GAPA(C0 = MFMA(kf2, qr[1], C0),    P0[10], P0[11], P0[12], P0[13], pw1[0] = PKW(P0, 8),  pw1[1] = PKW(P0, 10), pw1); \
            GAPA(C1 = MFMA(kf3, qr[1], C1),    P0[14], P0[15], P1[0], P1[1],   pw1[2] = PKW(P0, 12), pw1[3] = PKW(P0, 14), pw1); \
            GAPA(C0 = MFMA(kf4, qr[2], C0),    P1[2], P1[3], P1[4], P1[5],     pw2[0] = PKW(P1, 0),  pw2[1] = PKW(P1, 2),  pw2); \
            GAPA(C1 = MFMA(kf5, qr[2], C1),    P1[6], P1[7], P1[8], P1[9],     pw2[2] = PKW(P1, 4),  pw2[3] = PKW(P1, 6),  pw2); \
            GAPA(C0 = MFMA(kf6, qr[3], C0),    P1[10], P1[11], P1[12], P1[13], pw3[0] = PKW(P1, 8),  pw3[1] = PKW(P1, 10), pw3); \
            GAPA(C1 = MFMA(kf7, qr[3], C1),    P1[14], P1[15], 0.f, 0.f,       pw3[2] = PKW(P1, 12), pw3[3] = PKW(P1, 14), pw3); \
        } else { \
            _Pragma("unroll") for (int r = 2; r < 16; ++r) sacc += P0[r]; _Pragma("unroll") for (int r = 0; r < 16; ++r) sacc += P1[r]; \
            pw0 = (u32x4){PKW(P0, 0), PKW(P0, 2), PKW(P0, 4), PKW(P0, 6)}; pw1 = (u32x4){PKW(P0, 8), PKW(P0, 10), PKW(P0, 12), PKW(P0, 14)}; \
            pw2 = (u32x4){PKW(P1, 0), PKW(P1, 2), PKW(P1, 4), PKW(P1, 6)}; pw3 = (u32x4){PKW(P1, 8), PKW(P1, 10), PKW(P1, 12), PKW(P1, 14)}; } \
        l_reg += sacc; } while (0)
#define MIDDLE(C0, C1, t) do { const int kfirst = 64 * ((t) - 1); \
        if (kfirst + 63 + 113 > qw0) { const LAS float* tb = tab + (64 + qw0 + r32 - kfirst - 4 * hi - 63); \
            _Pragma("unroll") for (int r = 0; r < 16; ++r) { const int c = (r & 3) + 8 * (r >> 2); C0[r] += ((volatile const LAS float*)tb)[63 - c]; C1[r] += ((volatile const LAS float*)tb)[31 - c]; } } \
        resc = false; \
        if (!fixedref) { const float rm = rowmax(C0, C1); \
        if (__builtin_expect(__any(rm > (float)THR), 0)) { const float dl = __builtin_fmaxf(rm, 0.f); mhat += dl; \
            _Pragma("unroll") for (int r = 0; r < 16; ++r) { C0[r] -= dl; C1[r] -= dl; cinit[r] -= dl; } \
            const float f = __builtin_amdgcn_exp2f(-dl); l_reg *= f; if (hi == 0) wsf[r32] = f; resc = true; } } } while (0)
#define PHASE_B(X0, X1, vso, DOEX, RDK) do { SBAR(); const lds_cptr vp_ = vp0 + (vso); const lds_cptr kp_ = kp0 + ks_rd; s16x4 vA[2], vB[2], vC[2]; VRD(vA, 0); VRD(vB, 1); SBAR(); \
        if (DOEX) { \
            GAPB(VRD(vC, 2),  (void)0, o[0] = MFMA(PAF(0), VFRAG(vA), o[0]), X0, 0);  GAPB(VRD(vA, 3),  (void)0, o[0] = MFMA(PAF(1), VFRAG(vB), o[0]), X0, 2); \
            GAPB(VRD(vB, 4),  KRD(RDK, 0),  o[0] = MFMA(PAF(2), VFRAG(vC), o[0]), X0, 4);  GAPB(VRD(vC, 5),  KRD(RDK, 1),  o[0] = MFMA(PAF(3), VFRAG(vA), o[0]), X0, 6); \
            GAPB(VRD(vA, 6),  KRD(RDK, 2),  o[1] = MFMA(PAF(0), VFRAG(vB), o[1]), X0, 8);  GAPB(VRD(vB, 7),  KRD(RDK, 3),  o[1] = MFMA(PAF(1), VFRAG(vC), o[1]), X0, 10); \
            GAPB(VRD(vC, 8),  KRD(RDK, 4),  o[1] = MFMA(PAF(2), VFRAG(vA), o[1]), X0, 12); GAPB(VRD(vA, 9),  KRD(RDK, 5),  o[1] = MFMA(PAF(3), VFRAG(vB), o[1]), X0, 14); \
            GAPB(VRD(vB, 10), KRD(RDK, 6),  o[2] = MFMA(PAF(0), VFRAG(vC), o[2]), X1, 0);  GAPB(VRD(vC, 11), KRD(RDK, 7),  o[2] = MFMA(PAF(1), VFRAG(vA), o[2]), X1, 2); \
            GAPB(VRD(vA, 12), (void)0, o[2] = MFMA(PAF(2), VFRAG(vB), o[2]), X1, 4);  GAPB(VRD(vB, 13), (void)0, o[2] = MFMA(PAF(3), VFRAG(vC), o[2]), X1, 6); \
            GAPB(VRD(vC, 14), (void)0, o[3] = MFMA(PAF(0), VFRAG(vA), o[3]), X1, 8);  GAPB(VRD(vA, 15), (void)0, o[3] = MFMA(PAF(1), VFRAG(vB), o[3]), X1, 10); \
            GAPB((void)0,     (void)0, o[3] = MFMA(PAF(2), VFRAG(vC), o[3]), X1, 12); GAPB((void)0,     (void)0, o[3] = MFMA(PAF(3), VFRAG(vA), o[3]), X1, 14); \
        } else { \
            GAPB0(VRD(vC, 2),  (void)0, o[0] = MFMA(PAF(0), VFRAG(vA), o[0])); GAPB0(VRD(vA, 3),  (void)0, o[0] = MFMA(PAF(1), VFRAG(vB), o[0])); \
            GAPB0(VRD(vB, 4),  KRD(RDK, 0),  o[0] = MFMA(PAF(2), VFRAG(vC), o[0])); GAPB0(VRD(vC, 5),  KRD(RDK, 1),  o[0] = MFMA(PAF(3), VFRAG(vA), o[0])); \
            GAPB0(VRD(vA, 6),  KRD(RDK, 2),  o[1] = MFMA(PAF(0), VFRAG(vB), o[1])); GAPB0(VRD(vB, 7),  KRD(RDK, 3),  o[1] = MFMA(PAF(1), VFRAG(vC), o[1])); \
            GAPB0(VRD(vC, 8),  KRD(RDK, 4),  o[1] = MFMA(PAF(2), VFRAG(vA), o[1])); GAPB0(VRD(vA, 9),  KRD(RDK, 5),  o[1] = MFMA(PAF(3), VFRAG(vB), o[1])); \
            GAPB0(VRD(vB, 10), KRD(RDK, 6),  o[2] = MFMA(PAF(0), VFRAG(vC), o[2])); GAPB0(VRD(vC, 11), KRD(RDK, 7),  o[2] = MFMA(PAF(1), VFRAG(vA), o[2])); \
            GAPB0(VRD(vA, 12), (void)0, o[2] = MFMA(PAF(2), VFRAG(vB), o[2])); GAPB0(VRD(vB, 13), (void)0, o[2] = MFMA(PAF(3), VFRAG(vC), o[2])); \
            GAPB0(VRD(vC, 14), (void)0, o[3] = MFMA(PAF(0), VFRAG(vA), o[3])); GAPB0(VRD(vA, 15), (void)0, o[3] = MFMA(PAF(1), VFRAG(vB), o[3])); \
            GAPB0((void)0,     (void)0, o[3] = MFMA(PAF(2), VFRAG(vC), o[3])); GAPB0((void)0,     (void)0, o[3] = MFMA(PAF(3), VFRAG(vA), o[3])); \
        } } while (0)
#define RESC() do { if (resc) { asm volatile("s_waitcnt lgkmcnt(0)" ::: "memory"); \
        _Pragma("unroll") for (int r = 0; r < 16; ++r) { const float fr_ = wsf[crow(r, hi)]; \
            _Pragma("unroll") for (int vb = 0; vb < 4; ++vb) o[vb][r] *= fr_; } } } while (0)
    int vs_prev = 0, vs_next = 2 * VSLOT;
    int ks_rd = 2 * KSLOT, ks_is = 0;
#define ROT() do { vs_prev = (vs_prev == 2 * VSLOT) ? 0 : vs_prev + VSLOT; vs_next = (vs_next == 2 * VSLOT) ? 0 : vs_next + VSLOT; \
        ks_rd = ks_is; ks_is = (ks_is == 2 * KSLOT) ? 0 : ks_is + KSLOT; } while (0)
#define STEP(C0, C1, P0, P1, t, DOQK, RDK) do { \
        if ((t) + 2 < NT) ATT_ISSUE_K((t) + 2, ks_is);     \
        if ((t) + 1 < NT) ATT_ISSUE_V((t) + 1, vs_next);   \
        PHASE_A(C0, C1, P0, P1, t, DOQK); \
        if (DOQK) { MIDDLE(C0, C1, t); } else resc = false; \
        PHASE_B(C0, C1, vs_prev, DOQK, RDK); \
        ATT_WAIT_BAR(); RESC(); ROT(); } while (0)
    f32x16 sA0, sA1, sB0, sB1;
    ATT_WAIT_BAR();
    { const lds_cptr kp_ = kp0; sA0 = cinit;
#pragma unroll
      for (int d0 = 0; d0 < 4; ++d0) sA0 = MFMA(KFR(2 * d0), qr[d0], sA0);
      if (q0 == 0) { const LAS float* tb = tab + (64 + qw0 + r32 + NMETA - 4 * hi - 11);
#pragma unroll
          for (int r = 0; r < 8; ++r) sA0[r] += ((volatile const LAS float*)tb)[11 - ((r & 3) + 8 * (r >> 2))]; }
      float a = MX3(sA0[0], sA0[1], sA0[2]), bq = MX3(sA0[3], sA0[4], sA0[5]); a = MX3(a, sA0[6], sA0[7]); float rm = __builtin_fmaxf(a, bq);
      { auto rr = __builtin_amdgcn_permlane32_swap(__float_as_uint(rm), __float_as_uint(rm), false, false); rm = __builtin_fmaxf(__uint_as_float(rr[0]), __uint_as_float(rr[1])); }
      mhat = rm;
#pragma unroll
      for (int r = 0; r < 16; ++r) cinit[r] -= rm;
#pragma unroll
      for (int r = 0; r < 8; ++r) sA0[r] = EX(sA0[r] - rm);
#pragma unroll
      for (int r = 8; r < 16; ++r) sA0[r] = 0.f;
#pragma unroll
      for (int r = 0; r < 16; ++r) sA1[r] = 0.f;
      { const lds_cptr kp_ = kp0 + KSLOT; kf0 = KFR(0); kf1 = KFR(1); kf2 = KFR(2); kf3 = KFR(3); kf4 = KFR(4); kf5 = KFR(5); kf6 = KFR(6); kf7 = KFR(7); } }
    ATT_WAIT_BAR();
    const bool last_act = (wq >= 2);
    bool fixedref;
    { float q1 = 0.f;
#pragma unroll
      for (int d0 = 0; d0 < 4; ++d0)
#pragma unroll
          for (int e = 0; e < 8; ++e) q1 += __builtin_fabsf(__uint_as_float(((unsigned)(unsigned short)qr[d0][e]) << 16));
      { auto rr = __builtin_amdgcn_permlane32_swap(__float_as_uint(q1), __float_as_uint(q1), false, false); q1 = __uint_as_float(rr[0]) + __uint_as_float(rr[1]); }
      const float kmx = __builtin_fmaxf(__uint_as_float(kmx_a), __uint_as_float(kmx_b)) * 1.01f;
      float bv = (lane < 32) ? bv_raw * LOG2E : -INFINITY;
#pragma unroll
      for (int o = 1; o < 32; o <<= 1) bv = __builtin_fmaxf(bv, __shfl_xor(bv, o));
      const float bmax = __shfl(bv, 0);
      fixedref = __all(q1 * kmx + bmax - mhat <= (float)FIXTHR) != 0; }
    int t = 1;
    for (; t + 2 < NT; t += 2) {
        STEP(sB0, sB1, sA0, sA1, t, true, true);
        STEP(sA0, sA1, sB0, sB1, t + 1, true, true);
    }
    STEP(sB0, sB1, sA0, sA1, t, true, true);
    STEP(sA0, sA1, sB0, sB1, t + 1, last_act, false);
    if (last_act) { resc = false; PHASE_A(sB0, sB1, sA0, sA1, NT, false); PHASE_B(sB0, sB1, vs_prev, false, false); }
#undef STEP
#undef ROT
#undef RESC
#undef PHASE_B
#undef MIDDLE
#undef PHASE_A
#undef GAPB0
#undef GAPB
#undef GAPA
#undef PAF
#undef VFRAG
#undef VRD
#undef EX
#undef PKW
#undef KFR
#undef MFMA
#undef PIN
#undef SBAR
#undef ATT_ISSUE_K
#undef ATT_ISSUE_V
#undef KRD
    { auto rr = __builtin_amdgcn_permlane32_swap(__float_as_uint(l_reg), __float_as_uint(l_reg), false, false); l_reg = __uint_as_float(rr[0]) + __uint_as_float(rr[1]); }
    if (hi == 0) wsf[32 + r32] = l_reg;
    asm volatile("s_waitcnt lgkmcnt(0)" ::: "memory");
    const float msc = mp ? lam : 1.0f;
    float rli[16];
#pragma unroll
    for (int r = 0; r < 16; ++r) rli[r] = msc * __builtin_amdgcn_rcpf(wsf[32 + crow(r, hi)]);
    ATT_WAIT_BAR();
    { LAS float* stg = (LAS float*)shm + mp * (QB * 128) + (32 * wq) * 128 + r32;
#pragma unroll
      for (int vb = 0; vb < 4; ++vb)
#pragma unroll
          for (int r = 0; r < 16; ++r) stg[crow(r, hi) * 128 + 32 * vb] = o[vb][r] * rli[r]; }
    ATT_LBAR();
    { const int row = tid >> 2, seg = tid & 3;
      const LAS f32x4* a = (const LAS f32x4*)((LAS float*)shm + row * 128 + seg * 32);
      const LAS f32x4* c = (const LAS f32x4*)((LAS float*)shm + QB * 128 + row * 128 + seg * 32);
      f32x4 dv[8]; float ss = 0.f;
#pragma unroll
      for (int i = 0; i < 8; ++i) { dv[i] = a[i] - c[i]; ss += (dv[i][0] * dv[i][0] + dv[i][1] * dv[i][1]) + (dv[i][2] * dv[i][2] + dv[i][3] * dv[i][3]); }
      ss += __shfl_xor(ss, 1); ss += __shfl_xor(ss, 2);
      const float rs = __builtin_amdgcn_rsqf(ss * (1.0f / 128.0f) + RMS_EPS) * (1.0f - LAMBDA_INIT);
      bf16_t* op = O + (rowb + q0 + row) * PITCH + h * 128 + seg * 32;
      const f32x4* gp = (const f32x4*)(subg + seg * 32);
#pragma unroll
      for (int i = 0; i < 4; ++i) { const f32x4 g0 = gp[2 * i], g1 = gp[2 * i + 1]; const f32x4 v0 = dv[2 * i] * rs * g0, v1 = dv[2 * i + 1] * rs * g1;
          u32x4 w; w.x = cvtpk(v0[0], v0[1]); w.y = cvtpk(v0[2], v0[3]); w.z = cvtpk(v1[0], v1[1]); w.w = cvtpk(v1[2], v1[3]);
          *(u32x4*)(op + 8 * i) = w; } }
    ATT_LBAR();
}
#undef MX3
}

namespace mrow {
template <int NB, int KSTEPS>
__device__ __forceinline__ bool partial_reduce(const bf16_t* A, int lda, const bf16_t* Bt, int K, const int (&nrow)[NB], int wave, int lane, LAS f32x4* red, f32x4 (&acc)[NB]) {
    const int fr = lane & 15, fq = lane >> 4;
    const size_t koff = (size_t)wave * (KSTEPS * 32) + fq * 8;
    const bf16_t* ap = A + (size_t)fr * lda + koff;
#pragma unroll
    for (int nb = 0; nb < NB; ++nb) acc[nb] = (f32x4){0.f, 0.f, 0.f, 0.f};
    constexpr int CH = 4;
#pragma unroll
    for (int s0 = 0; s0 < KSTEPS; s0 += CH) {
        bf16x8 a[CH], b[NB][CH];
#pragma unroll
        for (int c = 0; c < CH; ++c) if (s0 + c < KSTEPS) a[c] = *(const bf16x8*)(ap + (s0 + c) * 32);
#pragma unroll
        for (int nb = 0; nb < NB; ++nb)
#pragma unroll
            for (int c = 0; c < CH; ++c) if (s0 + c < KSTEPS) b[nb][c] = *(const bf16x8*)(Bt + (size_t)(nrow[nb] + fr) * K + koff + (s0 + c) * 32);
#pragma unroll
        for (int nb = 0; nb < NB; ++nb)
#pragma unroll
            for (int c = 0; c < CH; ++c) if (s0 + c < KSTEPS) acc[nb] = __builtin_amdgcn_mfma_f32_16x16x32_bf16(b[nb][c], a[c], acc[nb], 0, 0, 0);
        __builtin_amdgcn_sched_barrier(0);
    }
#pragma unroll
    for (int nb = 0; nb < NB; ++nb) red[(wave * NB + nb) * 64 + lane] = acc[nb];
    __syncthreads();
    if (wave != 0) return false;
#pragma unroll
    for (int nb = 0; nb < NB; ++nb) { f32x4 t = red[nb * 64 + lane];
#pragma unroll
        for (int w = 1; w < 8; ++w) t += red[(w * NB + nb) * 64 + lane];
        acc[nb] = t; }
    return true;
}
}

#ifndef REP_GU
#define REP_GU 1
#endif
#ifndef REP_MISC
#define REP_MISC 1
#endif
#ifndef REP_P5
#define REP_P5 1
#endif
#ifndef PHASE_MASK
#define PHASE_MASK 0x3ff
#endif
constexpr int NWAVES = 8;
constexpr size_t MiB = 1u << 20;
constexpr size_t WS_CTL = 0, CTL_ZERO_BYTES = 1 * MiB;
constexpr size_t WS_WPOOL = 1 * MiB, WS_WGU0 = 2 * MiB, WS_WD0 = 13 * MiB, WS_WQKV = 19 * MiB, WS_WO = 25 * MiB, WS_WGU1 = 27 * MiB, WS_WD1 = 38 * MiB;
constexpr size_t WS_SSQ = 44 * MiB;
constexpr size_t WS_H = 48 * MiB;
constexpr size_t WS_HB = 178 * MiB;
constexpr size_t WS_ACT = 243 * MiB;
constexpr size_t QKV_STRIDE = (size_t)MPAD * D;
constexpr size_t WS_O = 437 * MiB;
constexpr size_t WS_END = 502 * MiB;
static_assert(WS_WGU0 + (size_t)2 * FF * D * 2 <= WS_WD0 && WS_WD0 + (size_t)FF * D * 2 <= WS_WQKV && WS_WQKV + (size_t)3 * D * D * 2 <= WS_WO && WS_WO + (size_t)D * D * 2 <= WS_WGU1, "ws map");
static_assert(WS_WGU1 + (size_t)2 * FF * D * 2 <= WS_WD1 && WS_WD1 + (size_t)FF * D * 2 <= WS_SSQ && WS_SSQ + (size_t)MPAD * 16 * 4 <= WS_H && WS_H + (size_t)MPAD * D * 4 <= WS_HB, "ws map");
static_assert(WS_HB + (size_t)MPAD * D * 2 <= WS_ACT && WS_ACT + (size_t)MPAD * FF * 2 <= WS_END && WS_ACT + 3 * QKV_STRIDE * 2 <= WS_O && WS_O + (size_t)MMAIN * D * 2 <= WS_END, "ws map");
constexpr int CW_BAR = 4096;
constexpr int CW_KMAX = 65536;

constexpr int RING_OFF = 0, RING_BYTES = 131072;
constexpr int LDSCTL_OFF = RING_BYTES, MISC_OFF = LDSCTL_OFF + 320;
constexpr int LDS_BYTES = 163840;

typedef GAS unsigned gu32;
#define RLX_AGENT __ATOMIC_RELAXED, __HIP_MEMORY_SCOPE_AGENT
#define LDS_WAIT() asm volatile("s_waitcnt lgkmcnt(0)" ::: "memory")

#define XB_TMO      128
#define XB_XCNT(j)  (256  + 64 * (j))
#define XB_XSUB(j)  (1280 + 64 * (j))
#define XB_XGEN(j)  (2304 + 64 * (j))
#define XB_TOP      3328
#define XB_TOPGEN   3392
#define XCD_BAR_WORDS 3456
#define XB_SPIN_CAP (1u << 18)
__device__ __forceinline__ unsigned xb_ld(unsigned* p)              { return __hip_atomic_load(p, __ATOMIC_RELAXED, __HIP_MEMORY_SCOPE_AGENT); }
__device__ __forceinline__ unsigned xb_add(unsigned* p, unsigned v) { return __hip_atomic_fetch_add(p, v, __ATOMIC_RELAXED, __HIP_MEMORY_SCOPE_AGENT); }
__device__ __forceinline__ unsigned xb_xcc_id() { return (unsigned)__builtin_amdgcn_s_getreg((3 << 11) | 20) & 0xFu; }
#define XB_SPIN(cond, bar) do { unsigned _sp = 0; while (cond) { __builtin_amdgcn_s_sleep(1); \
    if ((++_sp & 255u) == 0u) { if (xb_ld(&(bar)[XB_TMO])) break; if (_sp > XB_SPIN_CAP) { atomicAdd(&(bar)[XB_TMO], 1u); break; } } } } while (0)
struct XcdBarrier { unsigned* bar; unsigned x; volatile LAS unsigned* st; };
__device__ __forceinline__ XcdBarrier xcd_barrier_post(unsigned* bar, volatile LAS unsigned* st) {
    XcdBarrier b; b.bar = bar; b.x = xb_xcc_id(); b.st = st;
    if (threadIdx.x == 0) (void)xb_add(&bar[XB_XCNT(b.x)], 1u);
    return b;
}
__device__ __forceinline__ void xcd_barrier_complete(unsigned* bar, unsigned x, unsigned& nloc, unsigned& nx) {
    const unsigned G = gridDim.x * gridDim.y * gridDim.z;
    unsigned sum, cnt, mine, sp = 0u;
    for (;;) {
        sum = 0u; cnt = 0u; mine = 0u;
#pragma unroll
        for (unsigned j = 0; j < 16; ++j) { const unsigned c = xb_ld(&bar[XB_XCNT(j)]); sum += c; cnt += (c > 0u) ? 1u : 0u; mine = (j == x) ? c : mine; }
        if (sum == G) break;
        __builtin_amdgcn_s_sleep(1);
        if ((++sp & 255u) == 0u) { if (xb_ld(&bar[XB_TMO])) break; if (sp > XB_SPIN_CAP) { atomicAdd(&bar[XB_TMO], 1u); break; } }
    }
    nloc = mine > 0u ? mine : 1u; nx = cnt > 0u ? cnt : 1u;
}
template <class F>
__device__ __forceinline__ void xcd_barrier_pf(const XcdBarrier& b, F&& between) {
    asm volatile("s_waitcnt vmcnt(0)" ::: "memory");
    __syncthreads();
    unsigned target = 0u;
    if (threadIdx.x == 0) {
        unsigned* bar = b.bar;
        __builtin_amdgcn_s_waitcnt(0);
        unsigned nloc = b.st[0], nx = b.st[1];
        if (nloc == 0u) { xcd_barrier_complete(bar, b.x, nloc, nx); b.st[0] = nloc; b.st[1] = nx; }
        asm volatile("buffer_inv sc1" ::: "memory");
        const unsigned old = xb_add(&bar[XB_XSUB(b.x)], 1u);
        const unsigned gen = old / nloc;
        if (old + 1u == (gen + 1u) * nloc) {
            __builtin_amdgcn_fence(__ATOMIC_RELEASE, "agent");
            asm volatile("s_waitcnt vmcnt(0)" ::: "memory");
            (void)xb_add(&bar[XB_TOP], 1u);
        }
        target = (gen + 1u) * nx;
    }
    between();
    if (threadIdx.x == 0) {
        unsigned* bar = b.bar;
        XB_SPIN(xb_ld(&bar[XB_TOP]) < target, bar);
        asm volatile("s_waitcnt vmcnt(0)" ::: "memory");
    }
    __syncthreads();
}
__device__ __forceinline__ void xcd_barrier(const XcdBarrier& b) { xcd_barrier_pf(b, [] {}); }

struct Args { const float* in[18]; float* out; unsigned char* ws; };

__device__ __forceinline__ void transpose_item(const float* W, int ldw, int k0, int n0, bf16_t* WT, int ldt, int wt_row0, const float* kgain, const float* nscale, LAS float* scr, int lane) {
    const int c4 = (lane & 7) * 4, kr = lane >> 3;
    f32x4 v[8];
#pragma unroll
    for (int i = 0; i < 8; ++i) v[i] = *(const f32x4*)(W + (size_t)(k0 + kr + 8 * i) * ldw + n0 + c4);
    f32x4 ns = {1.f, 1.f, 1.f, 1.f};
    if (nscale) ns = *(const f32x4*)(nscale + n0 + c4);
#pragma unroll
    for (int i = 0; i < 8; ++i) { const int kk = kr + 8 * i; f32x4 t = v[i] * ns; if (kgain) t = t * kgain[k0 + kk];
        LAS float* d = scr + kk * 33 + c4; d[0] = t[0]; d[1] = t[1]; d[2] = t[2]; d[3] = t[3]; }
    LDS_WAIT(); asm volatile("" ::: "memory");
    const int c = lane & 7;
#pragma unroll
    for (int j = 0; j < 4; ++j) { const int n = (lane >> 3) + 8 * j; const LAS float* sp = scr + (8 * c) * 33 + n;
        u32x4 o; o[0] = cvtpk(sp[0 * 33], sp[1 * 33]); o[1] = cvtpk(sp[2 * 33], sp[3 * 33]); o[2] = cvtpk(sp[4 * 33], sp[5 * 33]); o[3] = cvtpk(sp[6 * 33], sp[7 * 33]);
        *(u32x4*)(WT + (size_t)(wt_row0 + n0 + n) * ldt + k0 + 8 * c) = o; }
    LDS_WAIT(); asm volatile("" ::: "memory");
}

__global__ void __launch_bounds__(NWAVES * 64, 2) fwd_megakernel(Args args) {
    extern __shared__ __attribute__((aligned(16))) unsigned char lds_raw[];
    LAS unsigned char* lds = (LAS unsigned char*)lds_raw;
    volatile LAS unsigned* MISC = (volatile LAS unsigned*)(lds + MISC_OFF);
    const int tid = threadIdx.x, lane = tid & 63, wave = __builtin_amdgcn_readfirstlane(tid >> 6);
    const int G = gridDim.x; const int bx = blockIdx.x; const int vcu = (G % 8 == 0) ? (bx % 8) * (G / 8) + bx / 8 : bx;
    gu32* ctl = (gu32*)(args.ws + WS_CTL);
#define x          (args.in[0])
#define meta       (args.in[1])
#define rel_bias   (args.in[2])
#define mix_g      (args.in[3])
#define ffn_g      (args.in[4])
#define pool_w     (args.in[5])
#define pool_scale (args.in[6])
#define w_qkv      (args.in[7])
#define w_o        (args.in[8])
#define lq1        (args.in[9])
#define lk1        (args.in[10])
#define lq2        (args.in[11])
#define lk2        (args.in[12])
#define subg       (args.in[13])
#define w_gate     (args.in[14])
#define w_up       (args.in[15])
#define w_down     (args.in[16])
#define fin_g      (args.in[17])
#define Wpool ((bf16_t*)(args.ws + WS_WPOOL))
#define Wgu0  ((bf16_t*)(args.ws + WS_WGU0))
#define Wd0   ((bf16_t*)(args.ws + WS_WD0))
#define Wqkv  ((bf16_t*)(args.ws + WS_WQKV))
#define Wo    ((bf16_t*)(args.ws + WS_WO))
#define Wgu1  ((bf16_t*)(args.ws + WS_WGU1))
#define Wd1   ((bf16_t*)(args.ws + WS_WD1))
#define SSQ   ((float*)(args.ws + WS_SSQ))
#define H     ((float*)(args.ws + WS_H))
#define HB    ((bf16_t*)(args.ws + WS_HB))
#define ACT   ((bf16_t*)(args.ws + WS_ACT))
#define QB_   ((bf16_t*)(args.ws + WS_ACT))
#define KB_   (QB_ + QKV_STRIDE)
#define VB_   (KB_ + QKV_STRIDE)
#define OB_   ((bf16_t*)(args.ws + WS_O))
    for (int u = tid; u < (LDS_BYTES - LDSCTL_OFF) / 4; u += NWAVES * 64) ((LAS unsigned*)(lds + LDSCTL_OFF))[u] = 0u;
    __syncthreads();
    XcdBarrier bar = xcd_barrier_post((unsigned*)(ctl + CW_BAR), MISC + 8);
    const int gw = vcu * NWAVES + wave, NGW = G * NWAVES;

    constexpr int I_POOL = 128, I_GU = 1408, I_DN = 1408, I_QKV = 1536, I_WO = 512;
#define CONVERT_ITEM(it_, scr_) do { int r = (it_); \
        if (r < I_POOL) { const int g = r >> 5, q = r & 31, kb = q >> 3, nb = q & 7; \
            transpose_item(pool_w + (size_t)g * 65536, 256, 64 * kb, 32 * nb, Wpool, 256, g * 256, nullptr, pool_scale + g * 256, scr_, lane); break; } \
        r -= I_POOL; \
        if (r < 4 * I_GU) { const int which = r / I_GU, q = r % I_GU, layer = which >> 1, isup = which & 1, kb = q / 88, nb = q % 88, n0 = 32 * nb; \
            const float* W = (isup ? w_up : w_gate) + (size_t)layer * D * FF; \
            transpose_item(W, FF, 64 * kb, n0, layer ? Wgu1 : Wgu0, D, 256 * (n0 >> 7) + 128 * isup + (n0 & 127) - n0, ffn_g + layer * D, nullptr, scr_, lane); break; } \
        r -= 4 * I_GU; \
        if (r < 2 * I_DN) { const int layer = r / I_DN, q = r % I_DN, kb = q >> 5, nb = q & 31; \
            transpose_item(w_down + (size_t)layer * FF * D, D, 64 * kb, 32 * nb, layer ? Wd1 : Wd0, FF, 0, nullptr, nullptr, scr_, lane); break; } \
        r -= 2 * I_DN; \
        if (r < I_QKV) { const int kb = r / 96, nb = r % 96; \
            transpose_item(w_qkv, 3 * D, 64 * kb, 32 * nb, Wqkv, D, 0, mix_g + D, nullptr, scr_, lane); break; } \
        r -= I_QKV; \
        { const int kb = r >> 5, nb = r & 31; transpose_item(w_o, D, 64 * kb, 32 * nb, Wo, D, 0, nullptr, nullptr, scr_, lane); } } while (0)
    if (PHASE_MASK & (1 << 0))
    {
        LAS float* scr = (LAS float*)(lds + RING_OFF + wave * 16384);
        constexpr int N_EARLY = I_POOL + 2 * I_GU + I_DN + I_QKV;
        for (int e = gw; e < N_EARLY; e += NGW) {
            const int it = e < I_POOL + 2 * I_GU ? e : (e < I_POOL + 2 * I_GU + I_DN ? e + 2 * I_GU : e + 2 * I_GU + I_DN);
            CONVERT_ITEM(it, scr);
        }
        __syncthreads();
        LAS float* hn = (LAS float*)(lds + RING_OFF);
        f32x4 gv[4];
#pragma unroll
        for (int j = 0; j < 4; ++j) gv[j] = *((const f32x4*)mix_g + lane + 64 * j);
        const int pg = tid >> 7, pw_ = 2 << pg;
        const LAS f32x2* pcol = (const LAS f32x2*)hn + tid;
#define POOL_SRC(b_, p_) (((p_) < NMETA) ? meta + (size_t)(p_) * D : x + ((size_t)(b_) * SEQ + ((p_) - NMETA)) * D)
#define POOL_LOAD(dst, src0, src1) do { const f32x4* a_ = (const f32x4*)(src0) + lane; const f32x4* b_ = (const f32x4*)(src1) + lane; \
            _Pragma("unroll") for (int j = 0; j < 4; ++j) { dst[j] = a_[64 * j]; dst[4 + j] = b_[64 * j]; } } while (0)
#define POOL_NORM_STORE(src, half) do { float s0_ = 0.f, s1_ = 0.f; \
            _Pragma("unroll") for (int j = 0; j < 4; ++j) { s0_ += (src[j][0] * src[j][0] + src[j][1] * src[j][1]) + (src[j][2] * src[j][2] + src[j][3] * src[j][3]); \
                                                            s1_ += (src[4 + j][0] * src[4 + j][0] + src[4 + j][1] * src[4 + j][1]) + (src[4 + j][2] * src[4 + j][2] + src[4 + j][3] * src[4 + j][3]); } \
            const float r0_ = __builtin_amdgcn_rsqf(wave_sum(s0_) * (1.0f / D) + RMS_EPS), r1_ = __builtin_amdgcn_rsqf(wave_sum(s1_) * (1.0f / D) + RMS_EPS); \
            LAS f32x4* d0_ = (LAS f32x4*)(hn + ((half) * 16 + 2 * wave) * 1024) + lane; \
            _Pragma("unroll") for (int j = 0; j < 4; ++j) { d0_[64 * j] = src[j] * r0_ * gv[j]; d0_[256 + 64 * j] = src[4 + j] * r1_ * gv[j]; } } while (0)
        for (int run = vcu; run < MMAIN / 128; run += G) {
            const int b = run >> 5, t0 = (run & 31) * 128;
            f32x4 RA[8], RB[8], RC[8];
            { const int p0_ = NMETA + t0 - 16 + 2 * wave; POOL_LOAD(RA, POOL_SRC(b, p0_), POOL_SRC(b, p0_ + 1)); }
            { const int p0_ = NMETA + t0 + 2 * wave; POOL_LOAD(RB, POOL_SRC(b, p0_), POOL_SRC(b, p0_ + 1)); }
            { const int p0_ = NMETA + t0 + 16 + 2 * wave; POOL_LOAD(RC, POOL_SRC(b, p0_), POOL_SRC(b, p0_ + 1)); }
            POOL_NORM_STORE(RA, 1);
#define POOL_STEP(st, Rcur, Rfree) do { const int half = (st) & 1; \
                POOL_NORM_STORE(Rcur, half); \
                if ((st) + 2 < 8) { const int p0_ = NMETA + t0 + 16 * ((st) + 2) + 2 * wave; POOL_LOAD(Rfree, POOL_SRC(b, p0_), POOL_SRC(b, p0_ + 1)); } \
                __syncthreads(); \
                { const int rb = 16 * half; f32x2 sm = {0.f, 0.f}; \
                  for (int i = 1; i < pw_; ++i) sm += pcol[((rb - i) & 31) * 512]; \
                  const float invw = 1.0f / (float)pw_; const size_t orow0 = (size_t)b * SEQ + t0 + 16 * (st); \
                  _Pragma("unroll") for (int o = 0; o < 16; ++o) { const f32x2 cur = pcol[(rb + o) * 512]; sm += cur; const f32x2 pv = sm * invw - cur; \
                      *(unsigned*)(HB + (orow0 + o) * D + 2 * tid) = cvtpk(pv[0], pv[1]); sm -= pcol[((rb + o - pw_ + 1) & 31) * 512]; } } \
                __syncthreads(); } while (0)
            POOL_STEP(0, RB, RA); POOL_STEP(1, RC, RB); POOL_STEP(2, RA, RC); POOL_STEP(3, RB, RA);
            POOL_STEP(4, RC, RB); POOL_STEP(5, RA, RC); POOL_STEP(6, RB, RA); POOL_STEP(7, RC, RB);
#undef POOL_STEP
        }
        if (vcu == 0) {
            f32x4 R[8];
            POOL_LOAD(R, meta + (size_t)(2 * wave) * D, meta + (size_t)(2 * wave + 1) * D);
            POOL_NORM_STORE(R, 0);
            { LAS f32x4* z = (LAS f32x4*)(hn + (16 + 2 * wave) * 1024) + lane;
#pragma unroll
              for (int j = 0; j < 8; ++j) z[64 * j] = (f32x4){0.f, 0.f, 0.f, 0.f}; }
            __syncthreads();
            f32x2 sm = {0.f, 0.f};
#pragma unroll
            for (int o = 0; o < 16; ++o) {
                const f32x2 cur = pcol[o * 512];
                sm += cur;
                const float ic = 1.0f / (float)((o + 1) < pw_ ? (o + 1) : pw_);
                const f32x2 pv = sm * ic - cur;
                *(unsigned*)(HB + ((size_t)META0 + o) * D + 2 * tid) = cvtpk(pv[0], pv[1]);
                sm -= pcol[((o - pw_ + 1) & 31) * 512];
            }
            __syncthreads();
        }
#undef POOL_SRC
#undef POOL_LOAD
#undef POOL_NORM_STORE
        for (int r = META0 + NMETA + gw; r < MPAD; r += NGW) { u32x4* p = (u32x4*)(HB + (size_t)r * D) + lane * 2; p[0] = (u32x4){0u, 0u, 0u, 0u}; p[1] = (u32x4){0u, 0u, 0u, 0u}; }
    }
    xcd_barrier(bar);

    if (PHASE_MASK & (1 << 1))
    {
        pg8::Gemm g{HB, Wpool, MPAD, D, 256, D, 256, MMAIN / 256}; pg8::StaticOrder S; S.init(MMAIN, D, G, bx);
        pg8::EpiRes E{x, MMAIN, meta, NMETA, nullptr, HB, SSQ};
        pg8::gemm_phase<pg8::EpiRes, pg8::StaticOrder, true>(lds + RING_OFF, g, S, E);
        pg8::MetaOrder SM{MMAIN / 256, D / 256, bx};
        pg8::gemm_phase<pg8::EpiRes, pg8::MetaOrder, true, true>(lds + RING_OFF, g, SM, E);
    }
    { pg8::Gemm gn_{HB, Wgu0, MPAD, 2 * FF, D, D, 0, MMAIN / 256}; pg8::StaticOrder Sn_; Sn_.init(MMAIN, 2 * FF, G, bx);
      xcd_barrier_pf(bar, [&] { pg8::prefetch_b<pg8::EpiSwiGLU, pg8::StaticOrder>(lds + RING_OFF, gn_, Sn_); }); }
    if (PHASE_MASK & (1 << 2))
    {
        pg8::Gemm g{HB, Wgu0, MPAD, 2 * FF, D, D, 0, MMAIN / 256}; pg8::StaticOrder S; S.init(MMAIN, 2 * FF, G, bx);
        pg8::EpiSwiGLU E{ACT, SSQ, (LAS const unsigned char*)(lds + RING_OFF + pg8::SSQ_LDS)};
        for (int rep = 0; rep < REP_GU; ++rep)
        pg8::gemm_phase<pg8::EpiSwiGLU, pg8::StaticOrder, true, false, true>(lds + RING_OFF, g, S, E);
        if (bx < FF / 16) {
            const int f0 = bx * 16; const int nrow[2] = {256 * (f0 >> 7) + (f0 & 127), 256 * (f0 >> 7) + 128 + (f0 & 127)};
            f32x4 macc[2];
            if (mrow::partial_reduce<2, D / 256>(HB + (size_t)META0 * D, D, Wgu0, D, nrow, wave, lane, (LAS f32x4*)(lds + RING_OFF), macc)) {
                const int row = META0 + (lane & 15); const float rs = pg8::row_rstd(SSQ, row);
                float o[4];
#pragma unroll
                for (int e = 0; e < 4; ++e) { const float gt = macc[0][e] * rs, up = macc[1][e] * rs; o[e] = gt * __builtin_amdgcn_rcpf(1.0f + __builtin_amdgcn_exp2f(-gt * LOG2E)) * up; }
                *(u32x2*)(ACT + (size_t)row * FF + f0 + 4 * (lane >> 4)) = (u32x2){cvtpk(o[0], o[1]), cvtpk(o[2], o[3])};
            }
            __syncthreads();
        }
    }
    { pg8::Gemm gn_{ACT, Wd0, MPAD, D, FF, FF, 0, MMAIN / 256}; pg8::StaticOrder Sn_; Sn_.init(MMAIN, D, G, bx);
      xcd_barrier_pf(bar, [&] { pg8::prefetch_b<pg8::EpiRes, pg8::StaticOrder>(lds + RING_OFF, gn_, Sn_); }); }
    if (PHASE_MASK & (1 << 3))
    {
        pg8::Gemm g{ACT, Wd0, MPAD, D, FF, FF, 0, MMAIN / 256}; pg8::StaticOrder S; S.init(MMAIN, D, G, bx);
        pg8::EpiRes E{nullptr, 0, nullptr, 0, HB, HB, SSQ};
        pg8::gemm_phase<pg8::EpiRes, pg8::StaticOrder, true, false, true>(lds + RING_OFF, g, S, E);
        if (bx < 16) {
            const int nrow[4] = {bx * 64, bx * 64 + 16, bx * 64 + 32, bx * 64 + 48};
            f32x4 macc[4];
            if (mrow::partial_reduce<4, FF / 256>(ACT + (size_t)META0 * FF, FF, Wd0, FF, nrow, wave, lane, (LAS f32x4*)(lds + RING_OFF), macc)) {
                const int row = META0 + (lane & 15); float ss = 0.f;
#pragma unroll
                for (int nb = 0; nb < 4; ++nb) { bf16_t* hp = HB + (size_t)row * D + nrow[nb] + 4 * (lane >> 4); const u32x2 rb = *(const u32x2*)hp;
                    const float v0 = macc[nb][0] + __uint_as_float(rb[0] << 16), v1 = macc[nb][1] + __uint_as_float(rb[0] & 0xffff0000u), v2 = macc[nb][2] + __uint_as_float(rb[1] << 16), v3 = macc[nb][3] + __uint_as_float(rb[1] & 0xffff0000u);
                    *(u32x2*)hp = (u32x2){cvtpk(v0, v1), cvtpk(v2, v3)}; ss += (v0 * v0 + v1 * v1) + (v2 * v2 + v3 * v3); }
                ss += __shfl_xor(ss, 16); ss += __shfl_xor(ss, 32);
                if (lane < 16) SSQ[(size_t)row * 16 + bx] = ss;
            }
            __syncthreads();
        }
        if (bx >= 16) {
            LAS float* scr = (LAS float*)(lds + RING_OFF + wave * 16384);
            constexpr int N_LATE = 2 * I_GU + I_DN + I_WO;
            const int lw = (bx - 16) * NWAVES + wave, nlw = (G - 16) * NWAVES;
            for (int l = lw; l < N_LATE; l += nlw) {
                const int it = l < 2 * I_GU ? I_POOL + 2 * I_GU + l : (l < 2 * I_GU + I_DN ? I_POOL + 4 * I_GU + I_DN + (l - 2 * I_GU) : I_POOL + 4 * I_GU + 2 * I_DN + I_QKV + (l - 2 * I_GU - I_DN));
                CONVERT_ITEM(it, scr);
            }
        }
    }
    { pg8::Gemm gn_{HB, Wqkv, MPAD, 3 * D, D, D, 0, MMAIN / 256}; pg8::StaticOrder Sn_; Sn_.init(MMAIN, 3 * D, G, bx);
      xcd_barrier_pf(bar, [&] { pg8::prefetch_b<pg8::EpiQKV, pg8::StaticOrder>(lds + RING_OFF, gn_, Sn_); }); }
    if (PHASE_MASK & (1 << 4))
    {
        pg8::Gemm g{HB, Wqkv, MPAD, 3 * D, D, D, 0, MMAIN / 256}; pg8::StaticOrder S; S.init(MMAIN, 3 * D, G, bx);
        pg8::EpiQKV E{QB_, QKV_STRIDE, SSQ, (unsigned*)(ctl + CW_KMAX), (LAS const unsigned char*)(lds + RING_OFF + pg8::SSQ_LDS)};
        for (int rep = 0; rep < REP_MISC; ++rep)
        pg8::gemm_phase<pg8::EpiQKV, pg8::StaticOrder, true, false, true>(lds + RING_OFF, g, S, E);
        if (bx < 3 * D / 16) {
            const int n0 = bx * 16; const int nrow[1] = {n0};
            f32x4 macc[1];
            if (mrow::partial_reduce<1, D / 256>(HB + (size_t)META0 * D, D, Wqkv, D, nrow, wave, lane, (LAS f32x4*)(lds + RING_OFF), macc)) {
                const int row = META0 + (lane & 15); const int t = n0 >> 10; const float rs = pg8::row_rstd(SSQ, row) * (t == 0 ? QSCALE : 1.0f);
                const f32x4 v = macc[0] * rs;
                *(u32x2*)(QB_ + (size_t)t * QKV_STRIDE + (size_t)row * D + (n0 & 1023) + 4 * (lane >> 4)) = (u32x2){cvtpk(v[0], v[1]), cvtpk(v[2], v[3])};
                if (t == 1) {
                    float mx = __builtin_fmaxf(__builtin_fmaxf(__builtin_fabsf(v[0]), __builtin_fabsf(v[1])), __builtin_fmaxf(__builtin_fabsf(v[2]), __builtin_fabsf(v[3])));
#pragma unroll
                    for (int o = 1; o < 64; o <<= 1) mx = __builtin_fmaxf(mx, __shfl_xor(mx, o));
                    if (lane == 0) atomicMax((unsigned*)(ctl + CW_KMAX) + 128 + ((n0 & 1023) >> 7) * 2 + ((n0 & 127) >> 6), __float_as_uint(mx));
                }
            }
            __syncthreads();
        }
    }
    xcd_barrier(bar);
    if (PHASE_MASK & (1 << 5))
    {
        float a1 = lq1[lane] * lk1[lane], a2 = lq2[lane] * lk2[lane];
        a1 = wave_sum(a1); a2 = wave_sum(a2);
        const float lam = __expf(a1) - __expf(a2) + LAMBDA_INIT;
        for (int rep = 0; rep < REP_P5; ++rep)
        for (int idx = vcu; idx < 2048; idx += G) {
            const int vv = idx & 255, i = idx >> 8, xg = vv >> 5, j = vv & 31, bh = xg * 8 + i, qb = (i & 1) ? 31 - j : j;
            att::attn_unit(bh >> 3, bh & 7, qb, QB_, KB_, VB_, OB_, lds + RING_OFF, rel_bias, subg, lam, (unsigned*)(ctl + CW_KMAX));
        }
    }
    { pg8::Gemm gn_{OB_, Wo, MMAIN, D, D, D, 0, MMAIN / 256}; pg8::StaticOrder Sn_; Sn_.init(MMAIN, D, G, bx);
      xcd_barrier_pf(bar, [&] { pg8::prefetch_b<pg8::EpiRes, pg8::StaticOrder>(lds + RING_OFF, gn_, Sn_); }); }
    if (PHASE_MASK & (1 << 6))
    {
        pg8::Gemm g{OB_, Wo, MMAIN, D, D, D, 0, MMAIN / 256}; pg8::StaticOrder S; S.init(MMAIN, D, G, bx);
        pg8::EpiRes E{nullptr, 0, nullptr, 0, HB, HB, SSQ};
        pg8::gemm_phase<pg8::EpiRes, pg8::StaticOrder, true, false, true>(lds + RING_OFF, g, S, E);
    }
    { pg8::Gemm gn_{HB, Wgu1, MMAIN, 2 * FF, D, D, 0, MMAIN / 256}; pg8::StaticOrder Sn_; Sn_.init(MMAIN, 2 * FF, G, bx);
      xcd_barrier_pf(bar, [&] { pg8::prefetch_b<pg8::EpiSwiGLU, pg8::StaticOrder>(lds + RING_OFF, gn_, Sn_); }); }
    if (PHASE_MASK & (1 << 7))
    {
        pg8::Gemm g{HB, Wgu1, MMAIN, 2 * FF, D, D, 0, MMAIN / 256}; pg8::StaticOrder S; S.init(MMAIN, 2 * FF, G, bx);
        pg8::EpiSwiGLU E{ACT, SSQ, (LAS const unsigned char*)(lds + RING_OFF + pg8::SSQ_LDS)};
        for (int rep = 0; rep < REP_GU; ++rep)
        pg8::gemm_phase<pg8::EpiSwiGLU, pg8::StaticOrder, true, false, true>(lds + RING_OFF, g, S, E);
    }
    { pg8::Gemm gn_{ACT, Wd1, MMAIN, D, FF, FF, 0, MMAIN / 256}; pg8::StaticOrder Sn_; Sn_.init(MMAIN, D, G, bx);
      xcd_barrier_pf(bar, [&] { pg8::prefetch_b<pg8::EpiRes, pg8::StaticOrder>(lds + RING_OFF, gn_, Sn_); }); }
    if (PHASE_MASK & (1 << 8))
    {
        pg8::Gemm g{ACT, Wd1, MMAIN, D, FF, FF, 0, MMAIN / 256}; pg8::StaticOrder S; S.init(MMAIN, D, G, bx);
        pg8::EpiRes E{nullptr, 0, nullptr, 0, HB, HB, SSQ};
        pg8::gemm_phase<pg8::EpiRes, pg8::StaticOrder, true, false, true>(lds + RING_OFF, g, S, E);
    }
    xcd_barrier(bar);
    if (PHASE_MASK & (1 << 9))
    {
        int lane9_ = (int)__builtin_amdgcn_mbcnt_hi(~0u, __builtin_amdgcn_mbcnt_lo(~0u, 0u)); asm volatile("" : "+v"(lane9_));
        const int lane = lane9_;
        f32x4 gv[4];
#pragma unroll
        for (int j = 0; j < 4; ++j) gv[j] = *((const f32x4*)fin_g + lane + 64 * j);
        const unsigned poison = xb_ld((unsigned*)(ctl + CW_BAR) + XB_TMO);
#define P9_LOAD(W, Q, r_) do { const int rr_ = (r_) < MMAIN ? (r_) : MMAIN - 1;     \
            const u32x2* hp_ = (const u32x2*)(HB + (size_t)rr_ * D) + lane; const f32x4* qp_ = (const f32x4*)(SSQ + (size_t)rr_ * 16); \
            _Pragma("unroll") for (int j = 0; j < 4; ++j) { W[j] = hp_[64 * j]; Q[j] = qp_[j]; } } while (0)
#define P9_FINISH(W, Q, r_) do { { \
            const float sq_ = ((Q[0][0] + Q[0][1]) + (Q[0][2] + Q[0][3])) + ((Q[1][0] + Q[1][1]) + (Q[1][2] + Q[1][3])) + ((Q[2][0] + Q[2][1]) + (Q[2][2] + Q[2][3])) + ((Q[3][0] + Q[3][1]) + (Q[3][2] + Q[3][3])); \
            float rs_ = __builtin_amdgcn_rsqf(sq_ * (1.0f / D) + RMS_EPS); if (poison) rs_ = __builtin_nanf(""); \
            f32x4* o_ = (f32x4*)(args.out + (size_t)(r_) * D) + lane; \
            _Pragma("unroll") for (int j = 0; j < 4; ++j) { const f32x4 v_ = {__uint_as_float(W[j][0] << 16), __uint_as_float(W[j][0] & 0xffff0000u), __uint_as_float(W[j][1] << 16), __uint_as_float(W[j][1] & 0xffff0000u)}; \
                o_[64 * j] = v_ * rs_ * gv[j]; } } } while (0)
        u32x2 wa[4], wb[4]; f32x4 qa[4], qb4[4];
#pragma unroll
        for (int j = 0; j < 4; ++j) { wa[j] = (u32x2){0u, 0u}; wb[j] = (u32x2){0u, 0u}; qa[j] = (f32x4){0.f, 0.f, 0.f, 0.f}; qb4[j] = (f32x4){0.f, 0.f, 0.f, 0.f}; }
        if (MMAIN % (2 * NGW) == 0) {
            P9_LOAD(wa, qa, gw);
            for (int r = gw; r < MMAIN; r += 2 * NGW) {
                P9_LOAD(wb, qb4, r + NGW);
                P9_FINISH(wa, qa, r);
                P9_LOAD(wa, qa, r + 2 * NGW);
                P9_FINISH(wb, qb4, r + NGW);
            }
        } else {
            for (int r = gw; r < MMAIN; r += NGW) { P9_LOAD(wa, qa, r); P9_FINISH(wa, qa, r); }
        }
#undef P9_LOAD
#undef P9_FINISH
    }
}

#undef CONVERT_ITEM
#undef x
#undef meta
#undef rel_bias
#undef mix_g
#undef ffn_g
#undef pool_w
#undef pool_scale
#undef w_qkv
#undef w_o
#undef lq1
#undef lk1
#undef lq2
#undef lk2
#undef subg
#undef w_gate
#undef w_up
#undef w_down
#undef fin_g
#undef Wpool
#undef Wgu0
#undef Wd0
#undef Wqkv
#undef Wo
#undef Wgu1
#undef Wd1
#undef SSQ
#undef H
#undef HB
#undef ACT
#undef QB_
#undef KB_
#undef VB_
#undef OB_

extern "C" void kernel_launch(void* const* d_in, const int* in_sizes, int n_in, void* d_out, int out_size, void* d_ws, size_t ws_size, hipStream_t stream) {
    static int grid = 0;
    if (grid == 0) {
        if (n_in != 18 || in_sizes[0] != MMAIN * D || out_size != MMAIN * D || ws_size < WS_END) {
            fprintf(stderr, "kernel_launch: unexpected shapes (n_in %d, in0 %d, out %d, ws %zu); nothing launched\n", n_in, n_in > 0 ? in_sizes[0] : -1, out_size, ws_size); grid = -1; return; }
        int dev = 0, cus = 0, per_cu = 0;
        if (hipGetDevice(&dev) != hipSuccess || hipDeviceGetAttribute(&cus, hipDeviceAttributeMultiprocessorCount, dev) != hipSuccess) { fprintf(stderr, "kernel_launch: device query failed\n"); grid = -1; return; }
        if (hipFuncSetAttribute((const void*)fwd_megakernel, hipFuncAttributeMaxDynamicSharedMemorySize, LDS_BYTES) != hipSuccess) { fprintf(stderr, "kernel_launch: hipFuncSetAttribute failed\n"); grid = -1; return; }
        if (hipOccupancyMaxActiveBlocksPerMultiprocessor(&per_cu, (const void*)fwd_megakernel, NWAVES * 64, LDS_BYTES) != hipSuccess || per_cu < 1) {
            fprintf(stderr, "kernel_launch: occupancy query reports %d workgroups per CU; nothing launched\n", per_cu); (void)hipGetLastError(); grid = -1; return; }
        grid = cus;
    }
    if (grid < 0) return;
    if (hipMemsetAsync((char*)d_ws + WS_CTL, 0, CTL_ZERO_BYTES, stream) != hipSuccess) { fprintf(stderr, "kernel_launch: hipMemsetAsync failed\n"); return; }
    Args a{};
    for (int i = 0; i < 18; ++i) a.in[i] = (const float*)d_in[i];
    a.out = (float*)d_out; a.ws = (unsigned char*)d_ws;
    hipLaunchKernelGGL(fwd_megakernel, dim3(grid), dim3(NWAVES * 64), LDS_BYTES, stream, a);
    const hipError_t le = hipPeekAtLastError();
    if (le != hipSuccess) fprintf(stderr, "kernel_launch: launch failed: %s\n", hipGetErrorName(le));
}
```

```cpp
#include <hip/hip_runtime.h>
#include <cstdio>
#include <cstdint>

#define LAS __attribute__((address_space(3)))
#define GAS __attribute__((address_space(1)))

typedef unsigned short bf16_t;
typedef short bf16x8 __attribute__((ext_vector_type(8)));
typedef short s16x4 __attribute__((ext_vector_type(4)));
typedef float f32x4 __attribute__((ext_vector_type(4)));
typedef float f32x2 __attribute__((ext_vector_type(2)));
typedef float f32x16 __attribute__((ext_vector_type(16)));
typedef unsigned u32x4 __attribute__((ext_vector_type(4)));
typedef unsigned u32x2 __attribute__((ext_vector_type(2)));
typedef __bf16 bf16x2_t __attribute__((ext_vector_type(2)));

constexpr int D = 1024, NB = 8, SEQ = 4096, NMETA = 16, FF = 2816, NH = 8;
constexpr int MMAIN = NB * SEQ;
constexpr int META0 = MMAIN;
constexpr int MPAD = MMAIN + 256;
constexpr float RMS_EPS = 1e-6f;
constexpr float LOG2E = 1.4426950408889634f;
constexpr float QSCALE = 0.125f * LOG2E;
constexpr float LAMBDA_INIT = 0.35550906759096926f;

__device__ __forceinline__ unsigned cvtpk(float lo, float hi) { f32x2 v = {lo, hi}; bf16x2_t b = __builtin_convertvector(v, bf16x2_t); return __builtin_bit_cast(unsigned, b); }
__device__ __forceinline__ float wave_sum(float v) {
#pragma unroll
    for (int o = 1; o < 64; o <<= 1) v += __shfl_xor(v, o);
    return v;
}

namespace pg8 {
constexpr int SSQ_LDS = 131072 + 8192;
constexpr int BM = 256, BK = 64, HALF = 128, HTB = HALF * BK * 2, STAGE_BYTES = 8 * HTB, NXCD = 8, WGM = 4;
__host__ __device__ __forceinline__ int img_byte(int row, int chunk) { return row * 128 + ((chunk ^ ((row >> 1) & 7)) << 4); }
__host__ __device__ __forceinline__ void stage_rc(int b, int& R, int& C) { R = b >> 7; C = ((((b >> 4) & 7) ^ ((R >> 1) & 7)) << 3); }
__host__ __device__ __forceinline__ int perm32(int rho) { const int n = rho >> 4, i = rho & 15; return 8 * (i >> 2) + 4 * n + (i & 3); }

struct Unit { int pm, pn; };
struct Gemm { const bf16_t* A; const bf16_t* Bt; int M, N, K; int lda; int a_pn_off; int m_full; };

struct StaticOrder {
    int nM, nN, nwg, G, c;
    __device__ void init(int M, int N, int G_, int c_) { nM = M / BM; nN = N / BM; nwg = nM * nN; G = G_; c = c_; }
    __device__ bool next(int i, Unit& u) const {
        const long L = (long)i * G + c; if (L >= nwg) return false;
        int wgid = (int)L; { const int q = nwg / NXCD, r = nwg % NXCD, xcd = wgid % NXCD, off = wgid / NXCD; wgid = (xcd < r ? xcd * (q + 1) : r * (q + 1) + (xcd - r) * q) + off; }
        const int nig = WGM * nN, gid = wgid / nig, fm = gid * WGM, gsz = (nM - fm) < WGM ? (nM - fm) : WGM;
        u.pm = fm + ((wgid % nig) % gsz); u.pn = (wgid % nig) / gsz; return true;
    }
};

struct MetaOrder {
    int pm, nN, c;
    __device__ bool next(int i, Unit& u) const { if (i > 0 || c >= nN) return false; u.pm = pm; u.pn = c; return true; }
};

__device__ __forceinline__ float row_rstd(const float* ssq, int row) {
    const f32x4* p = (const f32x4*)(ssq + (size_t)row * 16);
    const f32x4 a = p[0], b = p[1], c = p[2], d = p[3];
    const float s = ((a[0] + a[1]) + (a[2] + a[3])) + ((b[0] + b[1]) + (b[2] + b[3])) + ((c[0] + c[1]) + (c[2] + c[3])) + ((d[0] + d[1]) + (d[2] + d[3]));
    return __builtin_amdgcn_rsqf(s * (1.0f / D) + RMS_EPS);
}

__device__ __forceinline__ float row_rstd_lds(LAS const unsigned char* blk, int r) {
    const LAS f32x4* p = (const LAS f32x4*)(blk + r * 64);
    const f32x4 a = p[0], b = p[1], c = p[2], d = p[3];
    const float s = ((a[0] + a[1]) + (a[2] + a[3])) + ((b[0] + b[1]) + (b[2] + b[3])) + ((c[0] + c[1]) + (c[2] + c[3])) + ((d[0] + d[1]) + (d[2] + d[3]));
    return __builtin_amdgcn_rsqf(s * (1.0f / D) + RMS_EPS);
}

struct EpiRes {
    static constexpr bool PERM = true; static constexpr bool RSTD_LDS = false; static constexpr int NSTORES = 16;
    const float* r_main; int n_main; const float* r_aux; int n_aux;
    const bf16_t* r_bf;
    bf16_t* Hb; float* ssq;
    __device__ __forceinline__ void finish(const f32x4 (&acc)[2][2][4][2], int ai, int m, int bj, int row, int col, const f32x4& r0, const f32x4& r1, float& s) const {
        const f32x4 v0 = acc[ai][bj][m][0] + r0, v1 = acc[ai][bj][m][1] + r1;
        u32x4 w; w[0] = cvtpk(v0[0], v0[1]); w[1] = cvtpk(v0[2], v0[3]); w[2] = cvtpk(v1[0], v1[1]); w[3] = cvtpk(v1[2], v1[3]);
        *(u32x4*)(Hb + (size_t)row * D + col) = w;
        s += (v0[0] * v0[0] + v0[1] * v0[1]) + (v0[2] * v0[2] + v0[3] * v0[3]) + (v1[0] * v1[0] + v1[1] * v1[1]) + (v1[2] * v1[2] + v1[3] * v1[3]);
    }
    __device__ __forceinline__ void operator()(const f32x4 (&acc)[2][2][4][2], const Unit& u, int wr, int wc, int fr, int fq) const {
        const int col0 = u.pn * BM + wc * 32 + 8 * fq;
        const int row0 = u.pm * BM + wr * 64 + fr;
        if (r_bf) {
            u32x4 rb[2][4][2];
#pragma unroll
            for (int ai = 0; ai < 2; ++ai)
#pragma unroll
                for (int m = 0; m < 4; ++m)
#pragma unroll
                    for (int bj = 0; bj < 2; ++bj) rb[ai][m][bj] = *(const u32x4*)(r_bf + (size_t)(row0 + ai * HALF + m * 16) * D + col0 + bj * HALF);
#pragma unroll
            for (int ai = 0; ai < 2; ++ai)
#pragma unroll
                for (int m = 0; m < 4; ++m) {
                    const int row = row0 + ai * HALF + m * 16;
                    float s = 0.f;
#pragma unroll
                    for (int bj = 0; bj < 2; ++bj) { const u32x4 q = rb[ai][m][bj];
                        const f32x4 r0 = {__uint_as_float(q[0] << 16), __uint_as_float(q[0] & 0xffff0000u), __uint_as_float(q[1] << 16), __uint_as_float(q[1] & 0xffff0000u)};
                        const f32x4 r1 = {__uint_as_float(q[2] << 16), __uint_as_float(q[2] & 0xffff0000u), __uint_as_float(q[3] << 16), __uint_as_float(q[3] & 0xffff0000u)};
                        finish(acc, ai, m, bj, row, col0 + bj * HALF, r0, r1, s); }
                    s += __shfl_xor(s, 16); s += __shfl_xor(s, 32);
                    if (fq == 0) ssq[(size_t)row * 16 + u.pn * 4 + wc] = s;
                }
        } else {
#pragma unroll
            for (int ai = 0; ai < 2; ++ai) {
                f32x4 rf[4][2][2];
#pragma unroll
                for (int m = 0; m < 4; ++m) {
                    const int row = row0 + ai * HALF + m * 16;
                    const float* rp = row < n_main ? r_main + (size_t)row * D : ((row - n_main) < n_aux ? r_aux + (size_t)(row - n_main) * D : nullptr);
#pragma unroll
                    for (int bj = 0; bj < 2; ++bj) { rf[m][bj][0] = (f32x4){0.f, 0.f, 0.f, 0.f}; rf[m][bj][1] = (f32x4){0.f, 0.f, 0.f, 0.f};
                        if (rp) { rf[m][bj][0] = *(const f32x4*)(rp + col0 + bj * HALF); rf[m][bj][1] = *(const f32x4*)(rp + col0 + bj * HALF + 4); } }
                }
#pragma unroll
                for (int m = 0; m < 4; ++m) {
                    const int row = row0 + ai * HALF + m * 16;
                    float s = 0.f;
#pragma unroll
                    for (int bj = 0; bj < 2; ++bj) finish(acc, ai, m, bj, row, col0 + bj * HALF, rf[m][bj][0], rf[m][bj][1], s);
                    s += __shfl_xor(s, 16); s += __shfl_xor(s, 32);
                    if (fq == 0) ssq[(size_t)row * 16 + u.pn * 4 + wc] = s;
                }
            }
        }
    }
};

struct EpiSwiGLU {
    static constexpr bool PERM = true; static constexpr bool RSTD_LDS = true; static constexpr int NSTORES = 8;
    bf16_t* ACT; const float* ssq; LAS const unsigned char* blk;
    __device__ __forceinline__ void operator()(const f32x4 (&acc)[2][2][4][2], const Unit& u, int wr, int wc, int fr, int fq) const {
        const int col0 = u.pn * HALF + wc * 32 + 8 * fq;
        const int ln = fq * 16 + fr;
        const float rsA = row_rstd_lds(blk, wr * 64 + ln), rsB = row_rstd_lds(blk, HALF + wr * 64 + ln);
#pragma unroll
        for (int ai = 0; ai < 2; ++ai)
#pragma unroll
            for (int m = 0; m < 4; ++m) {
                const int row = u.pm * BM + ai * HALF + wr * 64 + m * 16 + fr;
                const float rs = __shfl(ai ? rsB : rsA, m * 16 + fr);
                float o[8];
#pragma unroll
                for (int n = 0; n < 2; ++n)
#pragma unroll
                    for (int e = 0; e < 4; ++e) {
                        const float g = acc[ai][0][m][n][e] * rs, up = acc[ai][1][m][n][e] * rs;
                        const float sg = __builtin_amdgcn_rcpf(1.0f + __builtin_amdgcn_exp2f(-g * LOG2E));
                        o[n * 4 + e] = g * sg * up;
                    }
                u32x4 w; w.x = cvtpk(o[0], o[1]); w.y = cvtpk(o[2], o[3]); w.z = cvtpk(o[4], o[5]); w.w = cvtpk(o[6], o[7]);
                *(u32x4*)(ACT + (size_t)row * FF + col0) = w;
            }
    }
};

struct EpiQKV {
    static constexpr bool PERM = true; static constexpr bool RSTD_LDS = true; static constexpr int NSTORES = 16;
    bf16_t* Q; size_t tstride; const float* ssq; unsigned* kmax; LAS const unsigned char* blk;
    __device__ __forceinline__ void operator()(const f32x4 (&acc)[2][2][4][2], const Unit& u, int wr, int wc, int fr, int fq) const {
        float kx0 = 0.f, kx1 = 0.f;
        const int t = u.pn >> 2; bf16_t* base = Q + (size_t)t * tstride; const float sc = (t == 0) ? QSCALE : 1.0f;
        const int col0 = (u.pn & 3) * BM + wc * 32 + 8 * fq;
        const int ln = fq * 16 + fr;
        const float rsA = row_rstd_lds(blk, wr * 64 + ln), rsB = row_rstd_lds(blk, HALF + wr * 64 + ln);
#pragma unroll
        for (int ai = 0; ai < 2; ++ai)
#pragma unroll
            for (int m = 0; m < 4; ++m) {
                const int row = u.pm * BM + ai * HALF + wr * 64 + m * 16 + fr;
                const float rs = __shfl(ai ? rsB : rsA, m * 16 + fr) * sc;
#pragma unroll
                for (int bj = 0; bj < 2; ++bj) {
                    const f32x4 v0 = acc[ai][bj][m][0] * rs, v1 = acc[ai][bj][m][1] * rs;
                    u32x4 w; w.x = cvtpk(v0[0], v0[1]); w.y = cvtpk(v0[2], v0[3]); w.z = cvtpk(v1[0], v1[1]); w.w = cvtpk(v1[2], v1[3]);
                    *(u32x4*)(base + (size_t)row * D + col0 + bj * HALF) = w;
                    if (t == 1) { const float mx = __builtin_fmaxf(__builtin_fmaxf(__builtin_fmaxf(__builtin_fabsf(v0[0]), __builtin_fabsf(v0[1])), __builtin_fmaxf(__builtin_fabsf(v0[2]), __builtin_fabsf(v0[3]))),
                                                              __builtin_fmaxf(__builtin_fmaxf(__builtin_fabsf(v1[0]), __builtin_fabsf(v1[1])), __builtin_fmaxf(__builtin_fabsf(v1[2]), __builtin_fabsf(v1[3]))));
                        if (bj == 0) kx0 = __builtin_fmaxf(kx0, mx); else kx1 = __builtin_fmaxf(kx1, mx); }
                }
            }
        if (t == 1) {
#pragma unroll
            for (int o = 1; o < 64; o <<= 1) { kx0 = __builtin_fmaxf(kx0, __shfl_xor(kx0, o)); kx1 = __builtin_fmaxf(kx1, __shfl_xor(kx1, o)); }
            if (fr == 0 && fq == 0) { unsigned* kp = kmax + (((u.pm >> 4) * 8 + (u.pn & 3) * 2) * 2 + (wc >> 1));
                atomicMax(kp, __float_as_uint(kx0)); atomicMax(kp + 2, __float_as_uint(kx1)); }
        }
    }
};

template <class Epi, class Sched, bool ALIGN_EPI, bool SHORT = false, bool BPRE = false>
__device__ __forceinline__ void gemm_phase(LAS unsigned char* lds, const Gemm g, const Sched& S, const Epi& E) {
    int tid_ = threadIdx.x; asm volatile("" : "+v"(tid_));
    const int tid = tid_, wid = __builtin_amdgcn_readfirstlane(tid >> 6), lane = tid & 63, wr = wid >> 2, wc = wid & 3, fr = lane & 15, fq = lane >> 4;
    const int K = g.K, nt = K / BK, lda = g.lda;
    unsigned voffA[2], voffB[2];
#pragma unroll
    for (int i = 0; i < 2; ++i) { int R, C; stage_rc(tid * 16 + i * 8192, R, C); const int Rb = Epi::PERM ? ((R & ~31) + perm32(R & 31)) : R;
        voffA[i] = (unsigned)((SHORT ? (R & 15) : R) * lda + C) * 2u; voffB[i] = (unsigned)(Rb * K + C) * 2u; }
    const size_t kstep = (size_t)(BK * 2);
    const size_t tstepA = (size_t)BM * lda * 2, hstepA = SHORT ? 0 : (size_t)HALF * lda * 2;
    const size_t hstepB = (size_t)HALF * K * 2, tstepB = 2 * hstepB;
    const size_t pnoffA = (size_t)g.a_pn_off * 2;
    const unsigned ldsdst = (unsigned)__builtin_amdgcn_readfirstlane((int)((unsigned)(uintptr_t)lds + (unsigned)wid * 1024u));
    const unsigned ldsssq = (unsigned)__builtin_amdgcn_readfirstlane((int)((unsigned)(uintptr_t)lds + (unsigned)SSQ_LDS + (unsigned)wid * 2048u));
    const int aoff = img_byte(wr * 64 + fr, fq), boff = img_byte(wc * 32 + fr, fq);
#define PG8_SA(b, h) (((b) * 2 + (h)) * HTB)
#define PG8_SB(b, h) ((4 + (b) * 2 + (h)) * HTB)
#define PG8_STAGE(bufoff, gbase, voff) do { _Pragma("unroll") for (int _i = 0; _i < 2; ++_i) \
        asm volatile("s_mov_b32 m0, %2\n\ts_nop 0\n\tglobal_load_lds_dwordx4 %0, %1" :: "v"((voff)[_i]), "s"((const char*)(gbase)), "s"(ldsdst + (unsigned)((bufoff) + _i * 8192)) : "memory"); } while (0)
#define PG8_LDA(dst, b, h) do { int a1_ = aoff; asm volatile("v_xor_b32 %0, 64, %0" : "+v"(a1_)); _Pragma("unroll") for (int m = 0; m < 4; ++m) { dst[m][0] = *(const LAS bf16x8*)(lds + PG8_SA(b, h) + aoff + m * 2048); dst[m][1] = *(const LAS bf16x8*)(lds + PG8_SA(b, h) + a1_ + m * 2048); } } while (0)
#define PG8_LDB(dst, b, h) do { int b1_ = boff; asm volatile("v_xor_b32 %0, 64, %0" : "+v"(b1_)); _Pragma("unroll") for (int n = 0; n < 2; ++n) { dst[n][0] = *(const LAS bf16x8*)(lds + PG8_SB(b, h) + boff + n * 2048); dst[n][1] = *(const LAS bf16x8*)(lds + PG8_SB(b, h) + b1_ + n * 2048); } } while (0)
#define PG8_MMA(ai, bj, At, Bt) do { if constexpr (!SHORT) { __builtin_amdgcn_s_setprio(1); _Pragma("unroll") for (int m = 0; m < 4; ++m) _Pragma("unroll") for (int n = 0; n < 2; ++n) _Pragma("unroll") for (int k = 0; k < 2; ++k) \
        acc[ai][bj][m][n] = __builtin_amdgcn_mfma_f32_16x16x32_bf16(Bt[n][k], At[m][k], acc[ai][bj][m][n], 0, 0, 0); __builtin_amdgcn_s_setprio(0); } \
      else if ((ai) == 0) { if (wr == 0) { _Pragma("unroll") for (int n = 0; n < 2; ++n) _Pragma("unroll") for (int k = 0; k < 2; ++k) \
        acc[0][bj][0][n] = __builtin_amdgcn_mfma_f32_16x16x32_bf16(Bt[n][k], At[0][k], acc[0][bj][0][n], 0, 0, 0); } } } while (0)
#define PG8_WAIT_V(n) asm volatile("s_waitcnt vmcnt(" #n ")" ::: "memory")
#define PG8_WAIT_VN(n) asm volatile("s_waitcnt vmcnt(%0)" :: "n"(n) : "memory")
#define PG8_WAIT_L(n) asm volatile("s_waitcnt lgkmcnt(" #n ")" ::: "memory")
#define PG8_BAR __builtin_amdgcn_s_barrier()
#define PG8_SCHED __builtin_amdgcn_sched_barrier(0)
    Unit cur, nxt; int ui = 0;
    if (!S.next(0, cur)) return;
    f32x4 acc[2][2][4][2];
#pragma unroll
    for (int a = 0; a < 2; ++a)
#pragma unroll
        for (int b = 0; b < 2; ++b)
#pragma unroll
            for (int m = 0; m < 4; ++m)
#pragma unroll
                for (int n = 0; n < 2; ++n) acc[a][b][m][n] = (f32x4){0.f, 0.f, 0.f, 0.f};
    bf16x8 At[4][2], B0[2][2], B1[2][2];
    const char* cA = (const char*)g.A + (size_t)cur.pm * tstepA + (size_t)cur.pn * pnoffA; const char* cB = (const char*)g.Bt + (size_t)cur.pn * tstepB;
    if constexpr (!BPRE) { PG8_STAGE(PG8_SB(0, 0), cB, voffB); PG8_STAGE(PG8_SB(0, 1), cB + hstepB, voffB); } PG8_STAGE(PG8_SA(0, 0), cA, voffA); PG8_STAGE(PG8_SA(0, 1), cA + hstepA, voffA);
    if (wr == 1) PG8_BAR;
    PG8_WAIT_V(2); PG8_BAR;
    if constexpr (!BPRE) PG8_STAGE(PG8_SB(1, 0), cB + kstep, voffB); PG8_STAGE(PG8_SA(1, 0), cA + kstep, voffA); if constexpr (!BPRE) PG8_STAGE(PG8_SB(1, 1), cB + hstepB + kstep, voffB);
    if constexpr (!SHORT) PG8_STAGE(PG8_SA(1, 1), cA + kstep + hstepA, voffA);
    if constexpr (SHORT) PG8_WAIT_V(6); else PG8_WAIT_V(0);
    PG8_BAR;
    for (;;) {
        const bool has_next = S.next(ui + 1, nxt);
        const char* nA = has_next ? (const char*)g.A + (size_t)nxt.pm * tstepA + (size_t)nxt.pn * pnoffA : cA; const char* nB = has_next ? (const char*)g.Bt + (size_t)nxt.pn * tstepB : cB;
#define PG8_SSQ(ON) do { if constexpr (Epi::RSTD_LDS && !SHORT) { if (ON) { const char* sb_ = (const char*)(E.ssq + (size_t)cur.pm * (BM * 16)); \
            _Pragma("unroll") for (int _i = 0; _i < 2; ++_i) asm volatile("s_mov_b32 m0, %2\n\ts_nop 0\n\tglobal_load_lds_dwordx4 %0, %1" :: "v"((unsigned)(wid * 2048 + _i * 1024 + lane * 16)), "s"(sb_), "s"(ldsssq + (unsigned)(_i * 1024)) : "memory"); } } } while (0)
#define PG8_ITER(W1, W2, W3, W4, STG11) do { \
            const bool last = (t == nt - 2); \
            const char* a1 = cA + (size_t)(t + 1) * kstep; \
            const char* a2 = last ? nA : cA + (size_t)(t + 2) * kstep; const char* b2 = last ? nB : cB + (size_t)(t + 2) * kstep; \
            const char* a3 = a2 + kstep; const char* b3 = b2 + kstep; \
              \
            PG8_LDB(B0, 0, 0); PG8_LDB(B1, 0, 1); PG8_SCHED; PG8_LDA(At, 0, 0); if (STG11) PG8_STAGE(PG8_SA(1, 1), a1 + hstepA, voffA); \
            PG8_WAIT_VN(W1); PG8_WAIT_L(0); PG8_BAR; PG8_MMA(0, 0, At, B0); PG8_MMA(0, 1, At, B1); PG8_BAR; PG8_SCHED; \
              \
            PG8_LDA(At, 0, 1); PG8_STAGE(PG8_SB(0, 0), b2, voffB); PG8_STAGE(PG8_SB(0, 1), b2 + hstepB, voffB); PG8_STAGE(PG8_SA(0, 0), a2, voffA); PG8_SSQ(!(STG11)); \
            PG8_WAIT_VN(W2); PG8_WAIT_L(0); PG8_BAR; PG8_MMA(1, 0, At, B0); PG8_MMA(1, 1, At, B1); PG8_BAR; PG8_SCHED; \
              \
            PG8_LDB(B0, 1, 0); PG8_LDB(B1, 1, 1); PG8_SCHED; PG8_LDA(At, 1, 0); PG8_STAGE(PG8_SA(0, 1), a2 + hstepA, voffA); \
            PG8_WAIT_VN(W3); PG8_WAIT_L(0); PG8_BAR; PG8_MMA(0, 0, At, B0); PG8_MMA(0, 1, At, B1); PG8_BAR; PG8_SCHED; \
              \
            PG8_LDA(At, 1, 1); PG8_STAGE(PG8_SB(1, 0), b3, voffB); PG8_STAGE(PG8_SB(1, 1), b3 + hstepB, voffB); PG8_STAGE(PG8_SA(1, 0), a3, voffA); \
            PG8_WAIT_VN(W4); PG8_WAIT_L(0); PG8_BAR; PG8_MMA(1, 0, At, B0); PG8_MMA(1, 1, At, B1); PG8_BAR; PG8_SCHED; } while (0)
        if constexpr (!SHORT) { { const int t = 0; constexpr int X = (Epi::RSTD_LDS ? 2 : 0);
              PG8_ITER(Epi::NSTORES + 2, Epi::NSTORES + 8 + X, Epi::NSTORES + 10 + X, Epi::NSTORES + 14 + X, false); }
            for (int t = 2; t < nt; t += 2) PG8_ITER(8, 8, 8, 8, true);
            PG8_STAGE(PG8_SA(1, 1), nA + kstep + hstepA, voffA); }
        else { for (int t = 0; t < nt; t += 2) PG8_ITER(8, 8, 8, 8, true); }
#undef PG8_ITER
#undef PG8_SSQ
        if constexpr (ALIGN_EPI) { if (wr == 0) PG8_BAR; }
        E(acc, cur, wr, wc, fr, fq);
        if (!has_next) break;
#pragma unroll
        for (int a = 0; a < 2; ++a)
#pragma unroll
            for (int b = 0; b < 2; ++b)
#pragma unroll
                for (int m = 0; m < 4; ++m)
#pragma unroll
                    for (int n = 0; n < 2; ++n) acc[a][b][m][n] = (f32x4){0.f, 0.f, 0.f, 0.f};
        cur = nxt; cA = nA; cB = nB; ++ui;
        if constexpr (ALIGN_EPI) { if (wr == 1) PG8_BAR; }
    }
    PG8_WAIT_V(0);
    if constexpr (!ALIGN_EPI) { if (wr == 0) PG8_BAR; }
    PG8_BAR;
#undef PG8_SA
#undef PG8_SB
#undef PG8_STAGE
#undef PG8_LDA
#undef PG8_LDB
#undef PG8_MMA
#undef PG8_WAIT_V
#undef PG8_WAIT_VN
#undef PG8_WAIT_L
#undef PG8_BAR
#undef PG8_SCHED
}
template <class Epi, class Sched>
__device__ __forceinline__ void prefetch_b(LAS unsigned char* lds, const Gemm g, const Sched& S) {
    int tid_ = threadIdx.x; asm volatile("" : "+v"(tid_));
    const int tid = tid_, wid = __builtin_amdgcn_readfirstlane(tid >> 6);
    Unit u; if (!S.next(0, u)) return;
    const int K = g.K;
    const size_t hstepB = (size_t)HALF * K * 2, kstep = (size_t)(BK * 2);
    const char* cB = (const char*)g.Bt + (size_t)u.pn * (2 * hstepB);
    const unsigned ldsdst = (unsigned)__builtin_amdgcn_readfirstlane((int)((unsigned)(uintptr_t)lds + (unsigned)wid * 1024u));
#pragma unroll
    for (int i = 0; i < 2; ++i) { int R, C; stage_rc(tid * 16 + i * 8192, R, C); const int Rb = Epi::PERM ? ((R & ~31) + perm32(R & 31)) : R;
        const unsigned vo = (unsigned)(Rb * K + C) * 2u;
#pragma unroll
        for (int q = 0; q < 4; ++q) {
            const char* src = cB + (q & 1) * hstepB + (q >> 1) * kstep;
            asm volatile("s_mov_b32 m0, %2\n\ts_nop 0\n\tglobal_load_lds_dwordx4 %0, %1" :: "v"(vo), "s"(src), "s"(ldsdst + (unsigned)((4 + (q >> 1) * 2 + (q & 1)) * HTB + i * 8192)) : "memory"); } }
}
}

namespace att {
typedef LAS const char* lds_cptr;
typedef short v4i16_t __attribute__((ext_vector_type(4)));
constexpr int PITCH = 1024, QB = 128, KVB = 64;
constexpr int KSLOT = 16384, VSLOT = 16384;
constexpr int LDS_V = 3 * KSLOT;
constexpr int LDS_TAB = LDS_V + 3 * VSLOT;
constexpr int LDS_WSF = LDS_TAB + 1152;
constexpr int THR = 8, FIXTHR = 80;
__device__ __forceinline__ int crow(int r, int hi) { return (r & 3) + 8 * (r >> 2) + 4 * hi; }
__device__ __forceinline__ void glds16(const void* gsrc, unsigned lds_dst) { unsigned keep;
    asm volatile("s_mov_b32 %0, m0\n\ts_mov_b32 m0, %2\n\ts_nop 0\n\tglobal_load_lds_dwordx4 %1, off\n\ts_mov_b32 m0, %0" : "=&s"(keep) : "v"(gsrc), "s"(lds_dst) : "memory"); }
__device__ __forceinline__ s16x4 vtr(lds_cptr p) { return __builtin_bit_cast(s16x4, __builtin_amdgcn_ds_read_tr16_b64_v4i16((LAS v4i16_t*)p)); }
#define ATT_WAIT_BAR() asm volatile("s_waitcnt vmcnt(0) lgkmcnt(0)\n\ts_barrier" ::: "memory")
#define ATT_LBAR() asm volatile("s_waitcnt lgkmcnt(0)\n\ts_barrier" ::: "memory")
#define MX3(a, b, c) __builtin_fmaxf(__builtin_fmaxf((a), (b)), (c))
__device__ __forceinline__ float rowmax(const f32x16& p0, const f32x16& p1) {
    float a = MX3(p0[0], p0[1], p1[0]), b = MX3(p0[2], p0[3], p1[1]); a = MX3(a, p1[2], p1[3]);
#pragma unroll
    for (int r = 4; r < 16; r += 4) { a = MX3(a, p0[r], p0[r + 1]); b = MX3(b, p0[r + 2], p0[r + 3]); a = MX3(a, p1[r], p1[r + 1]); b = MX3(b, p1[r + 2], p1[r + 3]); }
    const float m = __builtin_fmaxf(a, b); auto rr = __builtin_amdgcn_permlane32_swap(__float_as_uint(m), __float_as_uint(m), false, false);
    return __builtin_fmaxf(__uint_as_float(rr[0]), __uint_as_float(rr[1]));
}
__device__ __forceinline__ int t5_bucket(int rel) {
    if (rel < 16) return rel;
    int b = 16;
    b += rel >= 19; b += rel >= 21; b += rel >= 24; b += rel >= 27; b += rel >= 31; b += rel >= 35; b += rel >= 40; b += rel >= 46;
    b += rel >= 52; b += rel >= 59; b += rel >= 67; b += rel >= 77; b += rel >= 87; b += rel >= 99; b += rel >= 113;
    return b;
}

__device__ __forceinline__ void attn_unit(int b, int h, int qb, const bf16_t* Q, const bf16_t* K, const bf16_t* V, bf16_t* O, LAS unsigned char* shm,
                                          const float* rel_bias, const float* subg, float lam, unsigned* kmax) {
    int tid_ = threadIdx.x; asm volatile("" : "+v"(tid_));
    const int tid = tid_, lane = tid & 63, r32 = lane & 31, hi = lane >> 5; const int wid = __builtin_amdgcn_readfirstlane(tid >> 6);
    const int mp = wid >> 2, wq = wid & 3;
    const int q0 = qb * QB, qw0 = q0 + 32 * wq;
    const long rowb = (long)b * SEQ;
    const unsigned lds0 = (unsigned)(uintptr_t)shm;
    LAS float* wsf = (LAS float*)(shm + LDS_WSF) + wid * 64;
    LAS float* tab = (LAS float*)(shm + LDS_TAB);
    const float cb = rel_bias[31 * NH + h] * LOG2E;
    if (tid < 288) { const int rel = tid - 64; tab[tid] = rel < 0 ? -INFINITY : (rel < 128 ? (rel_bias[t5_bucket(rel) * NH + h] - rel_bias[31 * NH + h]) * LOG2E : 0.f); }
#define ATT_ISSUE_K(t, koff) do { \
        const long krow_ = ((t) == 0) ? (long)META0 : rowb + 64 * ((t) - 1); \
        const bf16_t* ks_ = K + (krow_ + lane) * PITCH + h * 128 + wid * 8; \
        glds16(ks_, (unsigned)__builtin_amdgcn_readfirstlane(lds0 + (koff) + wid * 1024)); \
        glds16(ks_ + 64, (unsigned)__builtin_amdgcn_readfirstlane(lds0 + (koff) + 8192 + wid * 1024)); } while (0)
#define ATT_ISSUE_V(t, voff) do { \
        const long vrow_ = ((t) == 0) ? (long)META0 : rowb + 64 * ((t) - 1); \
        const bf16_t* vs_ = V + (vrow_ + 16 * (wid & 3) + (lane >> 2)) * PITCH + h * 128 + 32 * (wid >> 2) + (lane & 3) * 8; \
        glds16(vs_, (unsigned)__builtin_amdgcn_readfirstlane(lds0 + LDS_V + (voff) + wid * 1024)); \
        glds16(vs_ + 64, (unsigned)__builtin_amdgcn_readfirstlane(lds0 + LDS_V + (voff) + 8192 + wid * 1024)); } while (0)
    const int NT = 1 + 2 * (qb + 1);
    ATT_ISSUE_K(0, 0); ATT_ISSUE_V(0, 0); ATT_ISSUE_K(1, KSLOT); ATT_ISSUE_V(1, VSLOT); ATT_ISSUE_K(2, 2 * KSLOT);
    bf16x8 qr[4];
    { const bf16_t* Qw = Q + (rowb + qw0 + r32) * PITCH + h * 128 + mp * 64 + hi * 8;
#pragma unroll
      for (int d0 = 0; d0 < 4; ++d0) qr[d0] = *(const bf16x8*)(Qw + d0 * 16); }
    const unsigned kmx_a = __hip_atomic_load(kmax + (b * 8 + h) * 2 + mp, __ATOMIC_RELAXED, __HIP_MEMORY_SCOPE_AGENT), kmx_b = __hip_atomic_load(kmax + 128 + h * 2 + mp, __ATOMIC_RELAXED, __HIP_MEMORY_SCOPE_AGENT);
    const float bv_raw = rel_bias[(lane & 31) * NH + h];
    float mhat = 0.f, l_reg = 0.f;
    f32x16 o[4];
#pragma unroll
    for (int vb = 0; vb < 4; ++vb) o[vb] = f32x16{};
    f32x16 cinit;
#pragma unroll
    for (int r = 0; r < 16; ++r) cinit[r] = cb;
    const lds_cptr shm3 = (lds_cptr)shm;
    const lds_cptr kp0 = shm3 + mp * 8192 + hi * 1024 + r32 * 16;
    const lds_cptr vp0 = shm3 + LDS_V + ((lane >> 4) & 1) * 32 + (lane & 3) * 8 + (4 * hi + ((lane & 15) >> 2)) * 64;
#define SBAR() __builtin_amdgcn_sched_barrier(0)
#define PIN(x) asm volatile("" : "+v"(x))
#define MFMA(a, b, c) __builtin_amdgcn_mfma_f32_32x32x16_bf16(a, b, c, 0, 0, 0)
#define KFR(j) (*(const LAS bf16x8*)(kp_ + ((j) >> 1) * 2048 + ((j) & 1) * 512))
#define KRD(F, j) do { if (F) kf##j = KFR(j); } while (0)
#define PKW(P, B) cvtpk(P[B], P[(B) + 1])
#define EX(v) __builtin_amdgcn_exp2f(v)
#define VRD(dst, h) do { dst[0] = vtr(vp_ + ((h) >> 2) * 4096 + ((h) & 3) * 1024); dst[1] = vtr(vp_ + ((h) >> 2) * 4096 + ((h) & 3) * 1024 + 512); } while (0)
#define VFRAG(src) ((bf16x8){src[0][0], src[0][1], src[0][2], src[0][3], src[1][0], src[1][1], src[1][2], src[1][3]})
#define PAF(k) __builtin_bit_cast(bf16x8, pw##k)
#define GAPA(MF, A0, A1, A2, A3, W0, W1, PW) do { MF; sacc += A0; sacc += A1; sacc += A2; sacc += A3; PIN(sacc); W0; W1; PIN(PW); SBAR(); } while (0)
#define GAPB(VR, KR, MF, X, B) do { VR; KR; MF; X[B] = EX(X[B]); X[(B) + 1] = EX(X[(B) + 1]); PIN(X); SBAR(); } while (0)
#define GAPB0(VR, KR, MF) do { VR; KR; MF; SBAR(); } while (0)
    u32x4 pw0, pw1, pw2, pw3;
    bf16x8 kf0, kf1, kf2, kf3, kf4, kf5, kf6, kf7;
    bool resc = false;
#define PHASE_A(C0, C1, P0, P1, t, DOQK) do { SBAR(); float sacc = P0[0] + P0[1]; \
        if (DOQK) { \
            GAPA(C0 = MFMA(kf0, qr[0], cinit), P0[2], P0[3], P0[4], P0[5],     pw0[0] = PKW(P0, 0),  pw0[1] = PKW(P0, 2),  pw0); \
            GAPA(C1 = MFMA(kf1, qr[0], cinit), P0[6], P0[7], P0[8], P0[9],     pw0[2] = PKW(P0, 4),  pw0[3] = PKW(P0, 6),  pw0); \
            GAPA(C0 = MFMA(kf2, qr[1], C0),    P0[10], P0[11], P0[12], P0[13], pw1[0] = PKW(P0, 8),  pw1[1] = PKW(P0, 10), pw1); \
            GAPA(C1 = MFMA(kf3, qr[1], C1),    P0[14], P0[15], P1[0], P1[1],   pw1[2] = PKW(P0, 12), pw1[3] = PKW(P0, 14), pw1); \
            GAPA(C0 = MFMA(kf4, qr[2], C0),    P1[2], P1[3], P1[4], P1[5],     pw2[0] = PKW(P1, 0),  pw2[1] = PKW(P1, 2),  pw2); \
            GAPA(C1 = MFMA(kf5, qr[2], C1),    P1[6], P1[7], P1[8], P1[9],     pw2[2] = PKW(P1, 4),  pw2[3] = PKW(P1, 6),  pw2); \
            GAPA(C0 = MFMA(kf6, qr[3], C0),    P1[10], P1[11], P1[12], P1[13], pw3[0] = PKW(P1, 8),  pw3[1] = PKW(P1, 10), pw3); \
            GAPA(C1 = MFMA(kf7, qr[3], C1),    P1[14], P1[15], 0.f, 0.f,       pw3[2] = PKW(P1, 12), pw3[3] = PKW(P1, 14), pw3); \
        } else { \
            _Pragma("unroll") for (int r = 2; r < 16; ++r) sacc += P0[r]; _Pragma("unroll") for (int r = 0; r < 16; ++r) sacc += P1[r]; \
            pw0 = (u32x4){PKW(P0, 0), PKW(P0, 2), PKW(P0, 4), PKW(P0, 6)}; pw1 = (u32x4){PKW(P0, 8), PKW(P0, 10), PKW(P0, 12), PKW(P0, 14)}; \
            pw2 = (u32x4){PKW(P1, 0), PKW(P1, 2), PKW(P1, 4), PKW(P1, 6)}; pw3 = (u32x4){PKW(P1, 8), PKW(P1, 10), PKW(P1, 12), PKW(P1, 14)}; } \
        l_reg += sacc; } while (0)
#define MIDDLE(C0, C1, t) do { const int kfirst = 64 * ((t) - 1); \
        if (kfirst + 63 + 113 > qw0) { const LAS float* tb = tab + (64 + qw0 + r32 - kfirst - 4 * hi - 63); \
            _Pragma("unroll") for (int r = 0; r < 16; ++r) { const int c = (r & 3) + 8 * (r >> 2); C0[r] += ((volatile const LAS float*)tb)[63 - c]; C1[r] += ((volatile const LAS float*)tb)[31 - c]; } } \
        resc = false; \
        if (!fixedref) { const float rm = rowmax(C0, C1); \
        if (__builtin_expect(__any(rm > (float)THR), 0)) { const float dl = __builtin_fmaxf(rm, 0.f); mhat += dl; \
            _Pragma("unroll") for (int r = 0; r < 16; ++r) { C0[r] -= dl; C1[r] -= dl; cinit[r] -= dl; } \
            const float f = __builtin_amdgcn_exp2f(-dl); l_reg *= f; if (hi == 0) wsf[r32] = f; resc = true; } } } while (0)
#define PHASE_B(X0, X1, vso, DOEX, RDK) do { SBAR(); const lds_cptr vp_ = vp0 + (vso); const lds_cptr kp_ = kp0 + ks_rd; s16x4 vA[2], vB[2], vC[2]; VRD(vA, 0); VRD(vB, 1); SBAR(); \
        if (DOEX) { \
            GAPB(VRD(vC, 2),  (void)0, o[0] = MFMA(PAF(0), VFRAG(vA), o[0]), X0, 0);  GAPB(VRD(vA, 3),  (void)0, o[0] = MFMA(PAF(1), VFRAG(vB), o[0]), X0, 2); \
            GAPB(VRD(vB, 4),  KRD(RDK, 0),  o[0] = MFMA(PAF(2), VFRAG(vC), o[0]), X0, 4);  GAPB(VRD(vC, 5),  KRD(RDK, 1),  o[0] = MFMA(PAF(3), VFRAG(vA), o[0]), X0, 6); \
            GAPB(VRD(vA, 6),  KRD(RDK, 2),  o[1] = MFMA(PAF(0), VFRAG(vB), o[1]), X0, 8);  GAPB(VRD(vB, 7),  KRD(RDK, 3),  o[1] = MFMA(PAF(1), VFRAG(vC), o[1]), X0, 10); \
            GAPB(VRD(vC, 8),  KRD(RDK, 4),  o[1] = MFMA(PAF(2), VFRAG(vA), o[1]), X0, 12); GAPB(VRD(vA, 9),  KRD(RDK, 5),  o[1] = MFMA(PAF(3), VFRAG(vB), o[1]), X0, 14); \
            GAPB(VRD(vB, 10), KRD(RDK, 6),  o[2] = MFMA(PAF(0), VFRAG(vC), o[2]), X1, 0);  GAPB(VRD(vC, 11), KRD(RDK, 7),  o[2] = MFMA(PAF(1), VFRAG(vA), o[2]), X1, 2); \
            GAPB(VRD(vA, 12), (void)0, o[2] = MFMA(PAF(2), VFRAG(vB), o[2]), X1, 4);  GAPB(VRD(vB, 13), (void)0, o[2] = MFMA(PAF(3), VFRAG(vC), o[2]), X1, 6); \
            GAPB(VRD(vC, 14), (void)0, o[3] = MFMA(PAF(0), VFRAG(vA), o[3]), X1, 8);  GAPB(VRD(vA, 15), (void)0, o[3] = MFMA(PAF(1), VFRAG(vB), o[3]), X1, 10); \
            GAPB((void)0,     (void)0, o[3] = MFMA(PAF(2), VFRAG(vC), o[3]), X1, 12); GAPB((void)0,     (void)0, o[3] = MFMA(PAF(3), VFRAG(vA), o[3]), X1, 14); \
        } else { \
            GAPB0(VRD(vC, 2),  (void)0, o[0] = MFMA(PAF(0), VFRAG(vA), o[0])); GAPB0(VRD(vA, 3),  (void)0, o[0] = MFMA(PAF(1), VFRAG(vB), o[0])); \
            GAPB0(VRD(vB, 4),  KRD(RDK, 0),  o[0] = MFMA(PAF(2), VFRAG(vC), o[0])); GAPB0(VRD(vC, 5),  KRD(RDK, 1),  o[0] = MFMA(PAF(3), VFRAG(vA), o[0])); \
            GAPB0(VRD(vA, 6),  KRD(RDK, 2),  o[1] = MFMA(PAF(0), VFRAG(vB), o[1])); GAPB0(VRD(vB, 7),  KRD(RDK, 3),  o[1] = MFMA(PAF(1), VFRAG(vC), o[1])); \
            GAPB0(VRD(vC, 8),  KRD(RDK, 4),  o[1] = MFMA(PAF(2), VFRAG(vA), o[1])); GAPB0(VRD(vA, 9),  KRD(RDK, 5),  o[1] = MFMA(PAF(3), VFRAG(vB), o[1])); \
            GAPB0(VRD(vB, 10), KRD(RDK, 6),  o[2] = MFMA(PAF(0), VFRAG(vC), o[2])); GAPB0(VRD(vC, 11), KRD(RDK, 7),  o[2] = MFMA(PAF(1), VFRAG(vA), o[2])); \
            GAPB0(VRD(vA, 12), (void)0, o[2] = MFMA(PAF(2), VFRAG(vB), o[2])); GAPB0(VRD(vB, 13), (void)0, o[2] = MFMA(PAF(3), VFRAG(vC), o[2])); \
            GAPB0(VRD(vC, 14), (void)0, o[3] = MFMA(PAF(0), VFRAG(vA), o[3])); GAPB0(VRD(vA, 15), (void)0, o[3] = MFMA(PAF(1), VFRAG(vB), o[3])); \
            GAPB0((void)0,     (void)0, o[3] = MFMA(PAF(2), VFRAG(vC), o[3])); GAPB0((void)0,     (void)0, o[3] = MFMA(PAF(3), VFRAG(vA), o[3])); \
        } } while (0)
#define RESC() do { if (resc) { asm volatile("s_waitcnt lgkmcnt(0)" ::: "memory"); \
        _Pragma("unroll") for (int r = 0; r < 16; ++r) { const float fr_ = wsf[crow(r, hi)]; \
            _Pragma("unroll") for (int vb = 0; vb < 4; ++vb) o[vb][r] *= fr_; } } } while (0)
    int vs_prev = 0, vs_next = 2 * VSLOT;
    int ks_rd = 2 * KSLOT, ks_is = 0;
#define ROT() do { vs_prev = (vs_prev == 2 * VSLOT) ? 0 : vs_prev + VSLOT; vs_next = (vs_next == 2 * VSLOT) ? 0 : vs_next + VSLOT; \
        ks_rd = ks_is; ks_is = (ks_is == 2 * KSLOT) ? 0 : ks_is + KSLOT; } while (0)
#define STEP(C0, C1, P0, P1, t, DOQK, RDK) do { \
        if ((t) + 2 < NT) ATT_ISSUE_K((t) + 2, ks_is);     \
        if ((t) + 1 < NT) ATT_ISSUE_V((t) + 1, vs_next);   \
        PHASE_A(C0, C1, P0, P1, t, DOQK); \
        if (DOQK) { MIDDLE(C0, C1, t); } else resc = false; \
        PHASE_B(C0, C1, vs_prev, DOQK, RDK); \
        ATT_WAIT_BAR(); RESC(); ROT(); } while (0)
    f32x16 sA0, sA1, sB0, sB1;
    ATT_WAIT_BAR();
    { const lds_cptr kp_ = kp0; sA0 = cinit;
#pragma unroll
      for (int d0 = 0; d0 < 4; ++d0) sA0 = MFMA(KFR(2 * d0), qr[d0], sA0);
      if (q0 == 0) { const LAS float* tb = tab + (64 + qw0 + r32 + NMETA - 4 * hi - 11);
#pragma unroll
          for (int r = 0; r < 8; ++r) sA0[r] += ((volatile const LAS float*)tb)[11 - ((r & 3) + 8 * (r >> 2))]; }
      float a = MX3(sA0[0], sA0[1], sA0[2]), bq = MX3(sA0[3], sA0[4], sA0[5]); a = MX3(a, sA0[6], sA0[7]); float rm = __builtin_fmaxf(a, bq);
      { auto rr = __builtin_amdgcn_permlane32_swap(__float_as_uint(rm), __float_as_uint(rm), false, false); rm = __builtin_fmaxf(__uint_as_float(rr[0]), __uint_as_float(rr[1])); }
      mhat = rm;
#pragma unroll
      for (int r = 0; r < 16; ++r) cinit[r] -= rm;
#pragma unroll
      for (int r = 0; r < 8; ++r) sA0[r] = EX(sA0[r] - rm);
#pragma unroll
      for (int r = 8; r < 16; ++r) sA0[r] = 0.f;
#pragma unroll
      for (int r = 0; r < 16; ++r) sA1[r] = 0.f;
      { const lds_cptr kp_ = kp0 + KSLOT; kf0 = KFR(0); kf1 = KFR(1); kf2 = KFR(2); kf3 = KFR(3); kf4 = KFR(4); kf5 = KFR(5); kf6 = KFR(6); kf7 = KFR(7); } }
    ATT_WAIT_BAR();
    const bool last_act = (wq >= 2);
    bool fixedref;
    { float q1 = 0.f;
#pragma unroll
      for (int d0 = 0; d0 < 4; ++d0)
#pragma unroll
          for (int e = 0; e < 8; ++e) q1 += __builtin_fabsf(__uint_as_float(((unsigned)(unsigned short)qr[d0][e]) << 16));
      { auto rr = __builtin_amdgcn_permlane32_swap(__float_as_uint(q1), __float_as_uint(q1), false, false); q1 = __uint_as_float(rr[0]) + __uint_as_float(rr[1]); }
      const float kmx = __builtin_fmaxf(__uint_as_float(kmx_a), __uint_as_float(kmx_b)) * 1.01f;
      float bv = (lane < 32) ? bv_raw * LOG2E : -INFINITY;
#pragma unroll
      for (int o = 1; o < 32; o <<= 1) bv = __builtin_fmaxf(bv, __shfl_xor(bv, o));
      const float bmax = __shfl(bv, 0);
      fixedref = __all(q1 * kmx + bmax - mhat <= (float)FIXTHR) != 0; }
    int t = 1;
    for (; t + 2 < NT; t += 2) {
        STEP(sB0, sB1, sA0, sA1, t, true, true);
        STEP(sA0, sA1, sB0, sB1, t + 1, true, true);
    }
    STEP(sB0, sB1, sA0, sA1, t, true, true);
    STEP(sA0, sA1, sB0, sB1, t + 1, last_act, false);
    if (last_act) { resc = false; PHASE_A(sB0, sB1, sA0, sA1, NT, false); PHASE_B(sB0, sB1, vs_prev, false, false); }
#undef STEP
#undef ROT
#undef RESC
#undef PHASE_B
#undef MIDDLE
#undef PHASE_A
#undef GAPB0
#undef GAPB
#undef GAPA
#undef PAF
#undef VFRAG
#undef VRD
#undef EX
#undef PKW
#undef KFR
#undef MFMA
#undef PIN
#undef SBAR
#undef ATT_ISSUE_K
#undef ATT_ISSUE_V
#undef KRD
    { auto rr = __builtin_amdgcn_permlane32_swap(__float_as_uint(l_reg), __float_as_uint(l_reg), false, false); l_reg = __uint_as_float(rr[0]) + __uint_as_float(rr[1]); }
    if (hi == 0) wsf[32 + r32] = l_reg;
    asm volatile("s_waitcnt lgkmcnt(0)" ::: "memory");
    const float msc = mp ? lam : 1.0f;
    float rli[16];
#pragma unroll
    for (int r = 0; r < 16; ++r) rli[r] = msc * __builtin_amdgcn_rcpf(wsf[32 + crow(r, hi)]);
    ATT_WAIT_BAR();
    { LAS float* stg = (LAS float*)shm + mp * (QB * 128) + (32 * wq) * 128 + r32;
#pragma unroll
      for (int vb = 0; vb < 4; ++vb)
#pragma unroll
          for (int r = 0; r < 16; ++r) stg[crow(r, hi) * 128 + 32 * vb] = o[vb][r] * rli[r]; }
    ATT_LBAR();
    { const int row = tid >> 2, seg = tid & 3;
      const LAS f32x4* a = (const LAS f32x4*)((LAS float*)shm + row * 128 + seg * 32);
      const LAS f32x4* c = (const LAS f32x4*)((LAS float*)shm + QB * 128 + row * 128 + seg * 32);
      f32x4 dv[8]; float ss = 0.f;
#pragma unroll
      for (int i = 0; i < 8; ++i) { dv[i] = a[i] - c[i]; ss += (dv[i][0] * dv[i][0] + dv[i][1] * dv[i][1]) + (dv[i][2] * dv[i][2] + dv[i][3] * dv[i][3]); }
      ss += __shfl_xor(ss, 1); ss += __shfl_xor(ss, 2);
      const float rs = __builtin_amdgcn_rsqf(ss * (1.0f / 128.0f) + RMS_EPS) * (1.0f - LAMBDA_INIT);
      bf16_t* op = O + (rowb + q0 + row) * PITCH + h * 128 + seg * 32;
      const f32x4* gp = (const f32x4*)(subg + seg * 32);
#pragma unroll
      for (int i = 0; i < 4; ++i) { const f32x4 g0 = gp[2 * i], g1 = gp[2 * i + 1]; const f32x4 v0 = dv[2 * i] * rs * g0, v1 = dv[2 * i + 1] * rs * g1;
          u32x4 w; w.x = cvtpk(v0[0], v0[1]); w.y = cvtpk(v0[2], v0[3]); w.z = cvtpk(v1[0], v1[1]); w.w = cvtpk(v1[2], v1[3]);
          *(u32x4*)(op + 8 * i) = w; } }
    ATT_LBAR();
}
#undef MX3
}

namespace mrow {
template <int NB, int KSTEPS>
__device__ __forceinline__ bool partial_reduce(const bf16_t* A, int lda, const bf16_t* Bt, int K, const int (&nrow)[NB], int wave, int lane, LAS f32x4* red, f32x4 (&acc)[NB]) {
    const int fr = lane & 15, fq = lane >> 4;
    const size_t koff = (size_t)wave * (KSTEPS * 32) + fq * 8;
    const bf16_t* ap = A + (size_t)fr * lda + koff;
#pragma unroll
    for (int nb = 0; nb < NB; ++nb) acc[nb] = (f32x4){0.f, 0.f, 0.f, 0.f};
    constexpr int CH = 4;
#pragma unroll
    for (int s0 = 0; s0 < KSTEPS; s0 += CH) {
        bf16x8 a[CH], b[NB][CH];
#pragma unroll
        for (int c = 0; c < CH; ++c) if (s0 + c < KSTEPS) a[c] = *(const bf16x8*)(ap + (s0 + c) * 32);
#pragma unroll
        for (int nb = 0; nb < NB; ++nb)
#pragma unroll
            for (int c = 0; c < CH; ++c) if (s0 + c < KSTEPS) b[nb][c] = *(const bf16x8*)(Bt + (size_t)(nrow[nb] + fr) * K + koff + (s0 + c) * 32);
#pragma unroll
        for (int nb = 0; nb < NB; ++nb)
#pragma unroll
            for (int c = 0; c < CH; ++c) if (s0 + c < KSTEPS) acc[nb] = __builtin_amdgcn_mfma_f32_16x16x32_bf16(b[nb][c], a[c], acc[nb], 0, 0, 0);
        __builtin_amdgcn_sched_barrier(0);
    }
#pragma unroll
    for (int nb = 0; nb < NB; ++nb) red[(wave * NB + nb) * 64 + lane] = acc[nb];
    __syncthreads();
    if (wave != 0) return false;
#pragma unroll
    for (int nb = 0; nb < NB; ++nb) { f32x4 t = red[nb * 64 + lane];
#pragma unroll
        for (int w = 1; w < 8; ++w) t += red[(w * NB + nb) * 64 + lane];
        acc[nb] = t; }
    return true;
}
}

#ifndef REP_GU
#define REP_GU 1
#endif
#ifndef REP_MISC
#define REP_MISC 1
#endif
#ifndef REP_P5
#define REP_P5 1
#endif
#ifndef PHASE_MASK
#define PHASE_MASK 0x3ff
#endif
constexpr int NWAVES = 8;
constexpr size_t MiB = 1u << 20;
constexpr size_t WS_CTL = 0, CTL_ZERO_BYTES = 1 * MiB;
constexpr size_t WS_WPOOL = 1 * MiB, WS_WGU0 = 2 * MiB, WS_WD0 = 13 * MiB, WS_WQKV = 19 * MiB, WS_WO = 25 * MiB, WS_WGU1 = 27 * MiB, WS_WD1 = 38 * MiB;
constexpr size_t WS_SSQ = 44 * MiB;
constexpr size_t WS_H = 48 * MiB;
constexpr size_t WS_HB = 178 * MiB;
constexpr size_t WS_ACT = 243 * MiB;
constexpr size_t QKV_STRIDE = (size_t)MPAD * D;
constexpr size_t WS_O = 437 * MiB;
constexpr size_t WS_END = 502 * MiB;
static_assert(WS_WGU0 + (size_t)2 * FF * D * 2 <= WS_WD0 && WS_WD0 + (size_t)FF * D * 2 <= WS_WQKV && WS_WQKV + (size_t)3 * D * D * 2 <= WS_WO && WS_WO + (size_t)D * D * 2 <= WS_WGU1, "ws map");
static_assert(WS_WGU1 + (size_t)2 * FF * D * 2 <= WS_WD1 && WS_WD1 + (size_t)FF * D * 2 <= WS_SSQ && WS_SSQ + (size_t)MPAD * 16 * 4 <= WS_H && WS_H + (size_t)MPAD * D * 4 <= WS_HB, "ws map");
static_assert(WS_HB + (size_t)MPAD * D * 2 <= WS_ACT && WS_ACT + (size_t)MPAD * FF * 2 <= WS_END && WS_ACT + 3 * QKV_STRIDE * 2 <= WS_O && WS_O + (size_t)MMAIN * D * 2 <= WS_END, "ws map");
constexpr int CW_BAR = 4096;
constexpr int CW_KMAX = 65536;

constexpr int RING_OFF = 0, RING_BYTES = 131072;
constexpr int LDSCTL_OFF = RING_BYTES, MISC_OFF = LDSCTL_OFF + 320;
constexpr int LDS_BYTES = 163840;

typedef GAS unsigned gu32;
#define RLX_AGENT __ATOMIC_RELAXED, __HIP_MEMORY_SCOPE_AGENT
#define LDS_WAIT() asm volatile("s_waitcnt lgkmcnt(0)" ::: "memory")

#define XB_TMO      128
#define XB_XCNT(j)  (256  + 64 * (j))
#define XB_XSUB(j)  (1280 + 64 * (j))
#define XB_XGEN(j)  (2304 + 64 * (j))
#define XB_TOP      3328
#define XB_TOPGEN   3392
#define XCD_BAR_WORDS 3456
#define XB_SPIN_CAP (1u << 18)
__device__ __forceinline__ unsigned xb_ld(unsigned* p)              { return __hip_atomic_load(p, __ATOMIC_RELAXED, __HIP_MEMORY_SCOPE_AGENT); }
__device__ __forceinline__ unsigned xb_add(unsigned* p, unsigned v) { return __hip_atomic_fetch_add(p, v, __ATOMIC_RELAXED, __HIP_MEMORY_SCOPE_AGENT); }
__device__ __forceinline__ unsigned xb_xcc_id() { return (unsigned)__builtin_amdgcn_s_getreg((3 << 11) | 20) & 0xFu; }
#define XB_SPIN(cond, bar) do { unsigned _sp = 0; while (cond) { __builtin_amdgcn_s_sleep(1); \
    if ((++_sp & 255u) == 0u) { if (xb_ld(&(bar)[XB_TMO])) break; if (_sp > XB_SPIN_CAP) { atomicAdd(&(bar)[XB_TMO], 1u); break; } } } } while (0)
struct XcdBarrier { unsigned* bar; unsigned x; volatile LAS unsigned* st; };
__device__ __forceinline__ XcdBarrier xcd_barrier_post(unsigned* bar, volatile LAS unsigned* st) {
    XcdBarrier b; b.bar = bar; b.x = xb_xcc_id(); b.st = st;
    if (threadIdx.x == 0) (void)xb_add(&bar[XB_XCNT(b.x)], 1u);
    return b;
}
__device__ __forceinline__ void xcd_barrier_complete(unsigned* bar, unsigned x, unsigned& nloc, unsigned& nx) {
    const unsigned G = gridDim.x * gridDim.y * gridDim.z;
    unsigned sum, cnt, mine, sp = 0u;
    for (;;) {
        sum = 0u; cnt = 0u; mine = 0u;
#pragma unroll
        for (unsigned j = 0; j < 16; ++j) { const unsigned c = xb_ld(&bar[XB_XCNT(j)]); sum += c; cnt += (c > 0u) ? 1u : 0u; mine = (j == x) ? c : mine; }
        if (sum == G) break;
        __builtin_amdgcn_s_sleep(1);
        if ((++sp & 255u) == 0u) { if (xb_ld(&bar[XB_TMO])) break; if (sp > XB_SPIN_CAP) { atomicAdd(&bar[XB_TMO], 1u); break; } }
    }
    nloc = mine > 0u ? mine : 1u; nx = cnt > 0u ? cnt : 1u;
}
template <class F>
__device__ __forceinline__ void xcd_barrier_pf(const XcdBarrier& b, F&& between) {
    asm volatile("s_waitcnt vmcnt(0)" ::: "memory");
    __syncthreads();
    unsigned target = 0u;
    if (threadIdx.x == 0) {
        unsigned* bar = b.bar;
        __builtin_amdgcn_s_waitcnt(0);
        unsigned nloc = b.st[0], nx = b.st[1];
        if (nloc == 0u) { xcd_barrier_complete(bar, b.x, nloc, nx); b.st[0] = nloc; b.st[1] = nx; }
        asm volatile("buffer_inv sc1" ::: "memory");
        const unsigned old = xb_add(&bar[XB_XSUB(b.x)], 1u);
        const unsigned gen = old / nloc;
        if (old + 1u == (gen + 1u) * nloc) {
            __builtin_amdgcn_fence(__ATOMIC_RELEASE, "agent");
            asm volatile("s_waitcnt vmcnt(0)" ::: "memory");
            (void)xb_add(&bar[XB_TOP], 1u);
        }
        target = (gen + 1u) * nx;
    }
    between();
    if (threadIdx.x == 0) {
        unsigned* bar = b.bar;
        XB_SPIN(xb_ld(&bar[XB_TOP]) < target, bar);
        asm volatile("s_waitcnt vmcnt(0)" ::: "memory");
    }
    __syncthreads();
}
__device__ __forceinline__ void xcd_barrier(const XcdBarrier& b) { xcd_barrier_pf(b, [] {}); }

struct Args { const float* in[18]; float* out; unsigned char* ws; };

__device__ __forceinline__ void transpose_item(const float* W, int ldw, int k0, int n0, bf16_t* WT, int ldt, int wt_row0, const float* kgain, const float* nscale, LAS float* scr, int lane) {
    const int c4 = (lane & 7) * 4, kr = lane >> 3;
    f32x4 v[8];
#pragma unroll
    for (int i = 0; i < 8; ++i) v[i] = *(const f32x4*)(W + (size_t)(k0 + kr + 8 * i) * ldw + n0 + c4);
    f32x4 ns = {1.f, 1.f, 1.f, 1.f};
    if (nscale) ns = *(const f32x4*)(nscale + n0 + c4);
#pragma unroll
    for (int i = 0; i < 8; ++i) { const int kk = kr + 8 * i; f32x4 t = v[i] * ns; if (kgain) t = t * kgain[k0 + kk];
        LAS float* d = scr + kk * 33 + c4; d[0] = t[0]; d[1] = t[1]; d[2] = t[2]; d[3] = t[3]; }
    LDS_WAIT(); asm volatile("" ::: "memory");
    const int c = lane & 7;
#pragma unroll
    for (int j = 0; j < 4; ++j) { const int n = (lane >> 3) + 8 * j; const LAS float* sp = scr + (8 * c) * 33 + n;
        u32x4 o; o[0] = cvtpk(sp[0 * 33], sp[1 * 33]); o[1] = cvtpk(sp[2 * 33], sp[3 * 33]); o[2] = cvtpk(sp[4 * 33], sp[5 * 33]); o[3] = cvtpk(sp[6 * 33], sp[7 * 33]);
        *(u32x4*)(WT + (size_t)(wt_row0 + n0 + n) * ldt + k0 + 8 * c) = o; }
    LDS_WAIT(); asm volatile("" ::: "memory");
}

__global__ void __launch_bounds__(NWAVES * 64, 2) fwd_megakernel(Args args) {
    extern __shared__ __attribute__((aligned(16))) unsigned char lds_raw[];
    LAS unsigned char* lds = (LAS unsigned char*)lds_raw;
    volatile LAS unsigned* MISC = (volatile LAS unsigned*)(lds + MISC_OFF);
    const int tid = threadIdx.x, lane = tid & 63, wave = __builtin_amdgcn_readfirstlane(tid >> 6);
    const int G = gridDim.x; const int bx = blockIdx.x; const int vcu = (G % 8 == 0) ? (bx % 8) * (G / 8) + bx / 8 : bx;
    gu32* ctl = (gu32*)(args.ws + WS_CTL);
#define x          (args.in[0])
#define meta       (args.in[1])
#define rel_bias   (args.in[2])
#define mix_g      (args.in[3])
#define ffn_g      (args.in[4])
#define pool_w     (args.in[5])
#define pool_scale (args.in[6])
#define w_qkv      (args.in[7])
#define w_o        (args.in[8])
#define lq1        (args.in[9])
#define lk1        (args.in[10])
#define lq2        (args.in[11])
#define lk2        (args.in[12])
#define subg       (args.in[13])
#define w_gate     (args.in[14])
#define w_up       (args.in[15])
#define w_down     (args.in[16])
#define fin_g      (args.in[17])
#define Wpool ((bf16_t*)(args.ws + WS_WPOOL))
#define Wgu0  ((bf16_t*)(args.ws + WS_WGU0))
#define Wd0   ((bf16_t*)(args.ws + WS_WD0))
#define Wqkv  ((bf16_t*)(args.ws + WS_WQKV))
#define Wo    ((bf16_t*)(args.ws + WS_WO))
#define Wgu1  ((bf16_t*)(args.ws + WS_WGU1))
#define Wd1   ((bf16_t*)(args.ws + WS_WD1))
#define SSQ   ((float*)(args.ws + WS_SSQ))
#define H     ((float*)(args.ws + WS_H))
#define HB    ((bf16_t*)(args.ws + WS_HB))
#define ACT   ((bf16_t*)(args.ws + WS_ACT))
#define QB_   ((bf16_t*)(args.ws + WS_ACT))
#define KB_   (QB_ + QKV_STRIDE)
#define VB_   (KB_ + QKV_STRIDE)
#define OB_   ((bf16_t*)(args.ws + WS_O))
    for (int u = tid; u < (LDS_BYTES - LDSCTL_OFF) / 4; u += NWAVES * 64) ((LAS unsigned*)(lds + LDSCTL_OFF))[u] = 0u;
    __syncthreads();
    XcdBarrier bar = xcd_barrier_post((unsigned*)(ctl + CW_BAR), MISC + 8);
    const int gw = vcu * NWAVES + wave, NGW = G * NWAVES;

    constexpr int I_POOL = 128, I_GU = 1408, I_DN = 1408, I_QKV = 1536, I_WO = 512;
#define CONVERT_ITEM(it_, scr_) do { int r = (it_); \
        if (r < I_POOL) { const int g = r >> 5, q = r & 31, kb = q >> 3, nb = q & 7; \
            transpose_item(pool_w + (size_t)g * 65536, 256, 64 * kb, 32 * nb, Wpool, 256, g * 256, nullptr, pool_scale + g * 256, scr_, lane); break; } \
        r -= I_POOL; \
        if (r < 4 * I_GU) { const int which = r / I_GU, q = r % I_GU, layer = which >> 1, isup = which & 1, kb = q / 88, nb = q % 88, n0 = 32 * nb; \
            const float* W = (isup ? w_up : w_gate) + (size_t)layer * D * FF; \
            transpose_item(W, FF, 64 * kb, n0, layer ? Wgu1 : Wgu0, D, 256 * (n0 >> 7) + 128 * isup + (n0 & 127) - n0, ffn_g + layer * D, nullptr, scr_, lane); break; } \
        r -= 4 * I_GU; \
        if (r < 2 * I_DN) { const int layer = r / I_DN, q = r % I_DN, kb = q >> 5, nb = q & 31; \
            transpose_item(w_down + (size_t)layer * FF * D, D, 64 * kb, 32 * nb, layer ? Wd1 : Wd0, FF, 0, nullptr, nullptr, scr_, lane); break; } \
        r -= 2 * I_DN; \
        if (r < I_QKV) { const int kb = r / 96, nb = r % 96; \
            transpose_item(w_qkv, 3 * D, 64 * kb, 32 * nb, Wqkv, D, 0, mix_g + D, nullptr, scr_, lane); break; } \
        r -= I_QKV; \
        { const int kb = r >> 5, nb = r & 31; transpose_item(w_o, D, 64 * kb, 32 * nb, Wo, D, 0, nullptr, nullptr, scr_, lane); } } while (0)
    if (PHASE_MASK & (1 << 0))
    {
        LAS float* scr = (LAS float*)(lds + RING_OFF + wave * 16384);
        constexpr int N_EARLY = I_POOL + 2 * I_GU + I_DN + I_QKV;
        for (int e = gw; e < N_EARLY; e += NGW) {
            const int it = e < I_POOL + 2 * I_GU ? e : (e < I_POOL + 2 * I_GU + I_DN ? e + 2 * I_GU : e + 2 * I_GU + I_DN);
            CONVERT_ITEM(it, scr);
        }
        __syncthreads();
        LAS float* hn = (LAS float*)(lds + RING_OFF);
        f32x4 gv[4];
#pragma unroll
        for (int j = 0; j < 4; ++j) gv[j] = *((const f32x4*)mix_g + lane + 64 * j);
        const int pg = tid >> 7, pw_ = 2 << pg;
        const LAS f32x2* pcol = (const LAS f32x2*)hn + tid;
#define POOL_SRC(b_, p_) (((p_) < NMETA) ? meta + (size_t)(p_) * D : x + ((size_t)(b_) * SEQ + ((p_) - NMETA)) * D)
#define POOL_LOAD(dst, src0, src1) do { const f32x4* a_ = (const f32x4*)(src0) + lane; const f32x4* b_ = (const f32x4*)(src1) + lane; \
            _Pragma("unroll") for (int j = 0; j < 4; ++j) { dst[j] = a_[64 * j]; dst[4 + j] = b_[64 * j]; } } while (0)
#define POOL_NORM_STORE(src, half) do { float s0_ = 0.f, s1_ = 0.f; \
            _Pragma("unroll") for (int j = 0; j < 4; ++j) { s0_ += (src[j][0] * src[j][0] + src[j][1] * src[j][1]) + (src[j][2] * src[j][2] + src[j][3] * src[j][3]); \
                                                            s1_ += (src[4 + j][0] * src[4 + j][0] + src[4 + j][1] * src[4 + j][1]) + (src[4 + j][2] * src[4 + j][2] + src[4 + j][3] * src[4 + j][3]); } \
            const float r0_ = __builtin_amdgcn_rsqf(wave_sum(s0_) * (1.0f / D) + RMS_EPS), r1_ = __builtin_amdgcn_rsqf(wave_sum(s1_) * (1.0f / D) + RMS_EPS); \
            LAS f32x4* d0_ = (LAS f32x4*)(hn + ((half) * 16 + 2 * wave) * 1024) + lane; \
            _Pragma("unroll") for (int j = 0; j < 4; ++j) { d0_[64 * j] = src[j] * r0_ * gv[j]; d0_[256 + 64 * j] = src[4 + j] * r1_ * gv[j]; } } while (0)
        for (int run = vcu; run < MMAIN / 128; run += G) {
            const int b = run >> 5, t0 = (run & 31) * 128;
            f32x4 RA[8], RB[8], RC[8];
            { const int p0_ = NMETA + t0 - 16 + 2 * wave; POOL_LOAD(RA, POOL_SRC(b, p0_), POOL_SRC(b, p0_ + 1)); }
            { const int p0_ = NMETA + t0 + 2 * wave; POOL_LOAD(RB, POOL_SRC(b, p0_), POOL_SRC(b, p0_ + 1)); }
            { const int p0_ = NMETA + t0 + 16 + 2 * wave; POOL_LOAD(RC, POOL_SRC(b, p0_), POOL_SRC(b, p0_ + 1)); }
            POOL_NORM_STORE(RA, 1);
#define POOL_STEP(st, Rcur, Rfree) do { const int half = (st) & 1; \
                POOL_NORM_STORE(Rcur, half); \
                if ((st) + 2 < 8) { const int p0_ = NMETA + t0 + 16 * ((st) + 2) + 2 * wave; POOL_LOAD(Rfree, POOL_SRC(b, p0_), POOL_SRC(b, p0_ + 1)); } \
                __syncthreads(); \
                { const int rb = 16 * half; f32x2 sm = {0.f, 0.f}; \
                  for (int i = 1; i < pw_; ++i) sm += pcol[((rb - i) & 31) * 512]; \
                  const float invw = 1.0f / (float)pw_; const size_t orow0 = (size_t)b * SEQ + t0 + 16 * (st); \
                  _Pragma("unroll") for (int o = 0; o < 16; ++o) { const f32x2 cur = pcol[(rb + o) * 512]; sm += cur; const f32x2 pv = sm * invw - cur; \
                      *(unsigned*)(HB + (orow0 + o) * D + 2 * tid) = cvtpk(pv[0], pv[1]); sm -= pcol[((rb + o - pw_ + 1) & 31) * 512]; } } \
                __syncthreads(); } while (0)
            POOL_STEP(0, RB, RA); POOL_STEP(1, RC, RB); POOL_STEP(2, RA, RC); POOL_STEP(3, RB, RA);
            POOL_STEP(4, RC, RB); POOL_STEP(5, RA, RC); POOL_STEP(6, RB, RA); POOL_STEP(7, RC, RB);
#undef POOL_STEP
        }
        if (vcu == 0) {
            f32x4 R[8];
            POOL_LOAD(R, meta + (size_t)(2 * wave) * D, meta + (size_t)(2 * wave + 1) * D);
            POOL_NORM_STORE(R, 0);
            { LAS f32x4* z = (LAS f32x4*)(hn + (16 + 2 * wave) * 1024) + lane;
#pragma unroll
              for (int j = 0; j < 8; ++j) z[64 * j] = (f32x4){0.f, 0.f, 0.f, 0.f}; }
            __syncthreads();
            f32x2 sm = {0.f, 0.f};
#pragma unroll
            for (int o = 0; o < 16; ++o) {
                const f32x2 cur = pcol[o * 512];
                sm += cur;
                const float ic = 1.0f / (float)((o + 1) < pw_ ? (o + 1) : pw_);
                const f32x2 pv = sm * ic - cur;
                *(unsigned*)(HB + ((size_t)META0 + o) * D + 2 * tid) = cvtpk(pv[0], pv[1]);
                sm -= pcol[((o - pw_ + 1) & 31) * 512];
            }
            __syncthreads();
        }
#undef POOL_SRC
#undef POOL_LOAD
#undef POOL_NORM_STORE
        for (int r = META0 + NMETA + gw; r < MPAD; r += NGW) { u32x4* p = (u32x4*)(HB + (size_t)r * D) + lane * 2; p[0] = (u32x4){0u, 0u, 0u, 0u}; p[1] = (u32x4){0u, 0u, 0u, 0u}; }
    }
    xcd_barrier(bar);

    if (PHASE_MASK & (1 << 1))
    {
        pg8::Gemm g{HB, Wpool, MPAD, D, 256, D, 256, MMAIN / 256}; pg8::StaticOrder S; S.init(MMAIN, D, G, bx);
        pg8::EpiRes E{x, MMAIN, meta, NMETA, nullptr, HB, SSQ};
        pg8::gemm_phase<pg8::EpiRes, pg8::StaticOrder, true>(lds + RING_OFF, g, S, E);
        pg8::MetaOrder SM{MMAIN / 256, D / 256, bx};
        pg8::gemm_phase<pg8::EpiRes, pg8::MetaOrder, true, true>(lds + RING_OFF, g, SM, E);
    }
    { pg8::Gemm gn_{HB, Wgu0, MPAD, 2 * FF, D, D, 0, MMAIN / 256}; pg8::StaticOrder Sn_; Sn_.init(MMAIN, 2 * FF, G, bx);
      xcd_barrier_pf(bar, [&] { pg8::prefetch_b<pg8::EpiSwiGLU, pg8::StaticOrder>(lds + RING_OFF, gn_, Sn_); }); }
    if (PHASE_MASK & (1 << 2))
    {
        pg8::Gemm g{HB, Wgu0, MPAD, 2 * FF, D, D, 0, MMAIN / 256}; pg8::StaticOrder S; S.init(MMAIN, 2 * FF, G, bx);
        pg8::EpiSwiGLU E{ACT, SSQ, (LAS const unsigned char*)(lds + RING_OFF + pg8::SSQ_LDS)};
        for (int rep = 0; rep < REP_GU; ++rep)
        pg8::gemm_phase<pg8::EpiSwiGLU, pg8::StaticOrder, true, false, true>(lds + RING_OFF, g, S, E);
        if (bx < FF / 16) {
            const int f0 = bx * 16; const int nrow[2] = {256 * (f0 >> 7) + (f0 & 127), 256 * (f0 >> 7) + 128 + (f0 & 127)};
            f32x4 macc[2];
            if (mrow::partial_reduce<2, D / 256>(HB + (size_t)META0 * D, D, Wgu0, D, nrow, wave, lane, (LAS f32x4*)(lds + RING_OFF), macc)) {
                const int row = META0 + (lane & 15); const float rs = pg8::row_rstd(SSQ, row);
                float o[4];
#pragma unroll
                for (int e = 0; e < 4; ++e) { const float gt = macc[0][e] * rs, up = macc[1][e] * rs; o[e] = gt * __builtin_amdgcn_rcpf(1.0f + __builtin_amdgcn_exp2f(-gt * LOG2E)) * up; }
                *(u32x2*)(ACT + (size_t)row * FF + f0 + 4 * (lane >> 4)) = (u32x2){cvtpk(o[0], o[1]), cvtpk(o[2], o[3])};
            }
            __syncthreads();
        }
    }
    { pg8::Gemm gn_{ACT, Wd0, MPAD, D, FF, FF, 0, MMAIN / 256}; pg8::StaticOrder Sn_; Sn_.init(MMAIN, D, G, bx);
      xcd_barrier_pf(bar, [&] { pg8::prefetch_b<pg8::EpiRes, pg8::StaticOrder>(lds + RING_OFF, gn_, Sn_); }); }
    if (PHASE_MASK & (1 << 3))
    {
        pg8::Gemm g{ACT, Wd0, MPAD, D, FF, FF, 0, MMAIN / 256}; pg8::StaticOrder S; S.init(MMAIN, D, G, bx);
        pg8::EpiRes E{nullptr, 0, nullptr, 0, HB, HB, SSQ};
        pg8::gemm_phase<pg8::EpiRes, pg8::StaticOrder, true, false, true>(lds + RING_OFF, g, S, E);
        if (bx < 16) {
            const int nrow[4] = {bx * 64, bx * 64 + 16, bx * 64 + 32, bx * 64 + 48};
            f32x4 macc[4];
            if (mrow::partial_reduce<4, FF / 256>(ACT + (size_t)META0 * FF, FF, Wd0, FF, nrow, wave, lane, (LAS f32x4*)(lds + RING_OFF), macc)) {
                const int row = META0 + (lane & 15); float ss = 0.f;
#pragma unroll
                for (int nb = 0; nb < 4; ++nb) { bf16_t* hp = HB + (size_t)row * D + nrow[nb] + 4 * (lane >> 4); const u32x2 rb = *(const u32x2*)hp;
                    const float v0 = macc[nb][0] + __uint_as_float(rb[0] << 16), v1 = macc[nb][1] + __uint_as_float(rb[0] & 0xffff0000u), v2 = macc[nb][2] + __uint_as_float(rb[1] << 16), v3 = macc[nb][3] + __uint_as_float(rb[1] & 0xffff0000u);
                    *(u32x2*)hp = (u32x2){cvtpk(v0, v1), cvtpk(v2, v3)}; ss += (v0 * v0 + v1 * v1) + (v2 * v2 + v3 * v3); }
                ss += __shfl_xor(ss, 16); ss += __shfl_xor(ss, 32);
                if (lane < 16) SSQ[(size_t)row * 16 + bx] = ss;
            }
            __syncthreads();
        }
        if (bx >= 16) {
            LAS float* scr = (LAS float*)(lds + RING_OFF + wave * 16384);
            constexpr int N_LATE = 2 * I_GU + I_DN + I_WO;
            const int lw = (bx - 16) * NWAVES + wave, nlw = (G - 16) * NWAVES;
            for (int l = lw; l < N_LATE; l += nlw) {
                const int it = l < 2 * I_GU ? I_POOL + 2 * I_GU + l : (l < 2 * I_GU + I_DN ? I_POOL + 4 * I_GU + I_DN + (l - 2 * I_GU) : I_POOL + 4 * I_GU + 2 * I_DN + I_QKV + (l - 2 * I_GU - I_DN));
                CONVERT_ITEM(it, scr);
            }
        }
    }
    { pg8::Gemm gn_{HB, Wqkv, MPAD, 3 * D, D, D, 0, MMAIN / 256}; pg8::StaticOrder Sn_; Sn_.init(MMAIN, 3 * D, G, bx);
      xcd_barrier_pf(bar, [&] { pg8::prefetch_b<pg8::EpiQKV, pg8::StaticOrder>(lds + RING_OFF, gn_, Sn_); }); }
    if (PHASE_MASK & (1 << 4))
    {
        pg8::Gemm g{HB, Wqkv, MPAD, 3 * D, D, D, 0, MMAIN / 256}; pg8::StaticOrder S; S.init(MMAIN, 3 * D, G, bx);
        pg8::EpiQKV E{QB_, QKV_STRIDE, SSQ, (unsigned*)(ctl + CW_KMAX), (LAS const unsigned char*)(lds + RING_OFF + pg8::SSQ_LDS)};
        for (int rep = 0; rep < REP_MISC; ++rep)
        pg8::gemm_phase<pg8::EpiQKV, pg8::StaticOrder, true, false, true>(lds + RING_OFF, g, S, E);
        if (bx < 3 * D / 16) {
            const int n0 = bx * 16; const int nrow[1] = {n0};
            f32x4 macc[1];
            if (mrow::partial_reduce<1, D / 256>(HB + (size_t)META0 * D, D, Wqkv, D, nrow, wave, lane, (LAS f32x4*)(lds + RING_OFF), macc)) {
                const int row = META0 + (lane & 15); const int t = n0 >> 10; const float rs = pg8::row_rstd(SSQ, row) * (t == 0 ? QSCALE : 1.0f);
                const f32x4 v = macc[0] * rs;
                *(u32x2*)(QB_ + (size_t)t * QKV_STRIDE + (size_t)row * D + (n0 & 1023) + 4 * (lane >> 4)) = (u32x2){cvtpk(v[0], v[1]), cvtpk(v[2], v[3])};
                if (t == 1) {
                    float mx = __builtin_fmaxf(__builtin_fmaxf(__builtin_fabsf(v[0]), __builtin_fabsf(v[1])), __builtin_fmaxf(__builtin_fabsf(v[2]), __builtin_fabsf(v[3])));
#pragma unroll
                    for (int o = 1; o < 64; o <<= 1) mx = __builtin_fmaxf(mx, __shfl_xor(mx, o));
                    if (lane == 0) atomicMax((unsigned*)(ctl + CW_KMAX) + 128 + ((n0 & 1023) >> 7) * 2 + ((n0 & 127) >> 6), __float_as_uint(mx));
                }
            }
            __syncthreads();
        }
    }
    xcd_barrier(bar);
    if (PHASE_MASK & (1 << 5))
    {
        float a1 = lq1[lane] * lk1[lane], a2 = lq2[lane] * lk2[lane];
        a1 = wave_sum(a1); a2 = wave_sum(a2);
        const float lam = __expf(a1) - __expf(a2) + LAMBDA_INIT;
        for (int rep = 0; rep < REP_P5; ++rep)
        for (int idx = vcu; idx < 2048; idx += G) {
            const int vv = idx & 255, i = idx >> 8, xg = vv >> 5, j = vv & 31, bh = xg * 8 + i, qb = (i & 1) ? 31 - j : j;
            att::attn_unit(bh >> 3, bh & 7, qb, QB_, KB_, VB_, OB_, lds + RING_OFF, rel_bias, subg, lam, (unsigned*)(ctl + CW_KMAX));
        }
    }
    { pg8::Gemm gn_{OB_, Wo, MMAIN, D, D, D, 0, MMAIN / 256}; pg8::StaticOrder Sn_; Sn_.init(MMAIN, D, G, bx);
      xcd_barrier_pf(bar, [&] { pg8::prefetch_b<pg8::EpiRes, pg8::StaticOrder>(lds + RING_OFF, gn_, Sn_); }); }
    if (PHASE_MASK & (1 << 6))
    {
        pg8::Gemm g{OB_, Wo, MMAIN, D, D, D, 0, MMAIN / 256}; pg8::StaticOrder S; S.init(MMAIN, D, G, bx);
        pg8::EpiRes E{nullptr, 0, nullptr, 0, HB, HB, SSQ};
        pg8::gemm_phase<pg8::EpiRes, pg8::StaticOrder, true, false, true>(lds + RING_OFF, g, S, E);
    }
    { pg8::Gemm gn_{HB, Wgu1, MMAIN, 2 * FF, D, D, 0, MMAIN / 256}; pg8::StaticOrder Sn_; Sn_.init(MMAIN, 2 * FF, G, bx);
      xcd_barrier_pf(bar, [&] { pg8::prefetch_b<pg8::EpiSwiGLU, pg8::StaticOrder>(lds + RING_OFF, gn_, Sn_); }); }
    if (PHASE_MASK & (1 << 7))
    {
        pg8::Gemm g{HB, Wgu1, MMAIN, 2 * FF, D, D, 0, MMAIN / 256}; pg8::StaticOrder S; S.init(MMAIN, 2 * FF, G, bx);
        pg8::EpiSwiGLU E{ACT, SSQ, (LAS const unsigned char*)(lds + RING_OFF + pg8::SSQ_LDS)};
        for (int rep = 0; rep < REP_GU; ++rep)
        pg8::gemm_phase<pg8::EpiSwiGLU, pg8::StaticOrder, true, false, true>(lds + RING_OFF, g, S, E);
    }
    { pg8::Gemm gn_{ACT, Wd1, MMAIN, D, FF, FF, 0, MMAIN / 256}; pg8::StaticOrder Sn_; Sn_.init(MMAIN, D, G, bx);
      xcd_barrier_pf(bar, [&] { pg8::prefetch_b<pg8::EpiRes, pg8::StaticOrder>(lds + RING_OFF, gn_, Sn_); }); }
    if (PHASE_MASK & (1 << 8))
    {
        pg8::Gemm g{ACT, Wd1, MMAIN, D, FF, FF, 0, MMAIN / 256}; pg8::StaticOrder S; S.init(MMAIN, D, G, bx);
        pg8::EpiRes E{nullptr, 0, nullptr, 0, HB, HB, SSQ};
        pg8::gemm_phase<pg8::EpiRes, pg8::StaticOrder, true, false, true>(lds + RING_OFF, g, S, E);
    }
    xcd_barrier(bar);
    if (PHASE_MASK & (1 << 9))
    {
        int lane9_ = (int)__builtin_amdgcn_mbcnt_hi(~0u, __builtin_amdgcn_mbcnt_lo(~0u, 0u)); asm volatile("" : "+v"(lane9_));
        const int lane = lane9_;
        f32x4 gv[4];
#pragma unroll
        for (int j = 0; j < 4; ++j) gv[j] = *((const f32x4*)fin_g + lane + 64 * j);
        const unsigned poison = xb_ld((unsigned*)(ctl + CW_BAR) + XB_TMO);
#define P9_LOAD(W, Q, r_) do { const int rr_ = (r_) < MMAIN ? (r_) : MMAIN - 1;     \
            const u32x2* hp_ = (const u32x2*)(HB + (size_t)rr_ * D) + lane; const f32x4* qp_ = (const f32x4*)(SSQ + (size_t)rr_ * 16); \
            _Pragma("unroll") for (int j = 0; j < 4; ++j) { W[j] = hp_[64 * j]; Q[j] = qp_[j]; } } while (0)
#define P9_FINISH(W, Q, r_) do { { \
            const float sq_ = ((Q[0][0] + Q[0][1]) + (Q[0][2] + Q[0][3])) + ((Q[1][0] + Q[1][1]) + (Q[1][2] + Q[1][3])) + ((Q[2][0] + Q[2][1]) + (Q[2][2] + Q[2][3])) + ((Q[3][0] + Q[3][1]) + (Q[3][2] + Q[3][3])); \
            float rs_ = __builtin_amdgcn_rsqf(sq_ * (1.0f / D) + RMS_EPS); if (poison) rs_ = __builtin_nanf(""); \
            f32x4* o_ = (f32x4*)(args.out + (size_t)(r_) * D) + lane; \
            _Pragma("unroll") for (int j = 0; j < 4; ++j) { const f32x4 v_ = {__uint_as_float(W[j][0] << 16), __uint_as_float(W[j][0] & 0xffff0000u), __uint_as_float(W[j][1] << 16), __uint_as_float(W[j][1] & 0xffff0000u)}; \
                o_[64 * j] = v_ * rs_ * gv[j]; } } } while (0)
        u32x2 wa[4], wb[4]; f32x4 qa[4], qb4[4];
#pragma unroll
        for (int j = 0; j < 4; ++j) { wa[j] = (u32x2){0u, 0u}; wb[j] = (u32x2){0u, 0u}; qa[j] = (f32x4){0.f, 0.f, 0.f, 0.f}; qb4[j] = (f32x4){0.f, 0.f, 0.f, 0.f}; }
        if (MMAIN % (2 * NGW) == 0) {
            P9_LOAD(wa, qa, gw);
            for (int r = gw; r < MMAIN; r += 2 * NGW) {
                P9_LOAD(wb, qb4, r + NGW);
                P9_FINISH(wa, qa, r);
                P9_LOAD(wa, qa, r + 2 * NGW);
                P9_FINISH(wb, qb4, r + NGW);
            }
        } else {
            for (int r = gw; r < MMAIN; r += NGW) { P9_LOAD(wa, qa, r); P9_FINISH(wa, qa, r); }
        }
#undef P9_LOAD
#undef P9_FINISH
    }
}

#undef CONVERT_ITEM
#undef x
#undef meta
#undef rel_bias
#undef mix_g
#undef ffn_g
#undef pool_w
#undef pool_scale
#undef w_qkv
#undef w_o
#undef lq1
#undef lk1
#undef lq2
#undef lk2
#undef subg
#undef w_gate
#undef w_up
#undef w_down
#undef fin_g
#undef Wpool
#undef Wgu0
#undef Wd0
#undef Wqkv
#undef Wo
#undef Wgu1
#undef Wd1
#undef SSQ
#undef H
#undef HB
#undef ACT
#undef QB_
#undef KB_
#undef VB_
#undef OB_

extern "C" void kernel_launch(void* const* d_in, const int* in_sizes, int n_in, void* d_out, int out_size, void* d_ws, size_t ws_size, hipStream_t stream) {
    static int grid = 0;
    if (grid == 0) {
        if (n_in != 18 || in_sizes[0] != MMAIN * D || out_size != MMAIN * D || ws_size < WS_END) {
            fprintf(stderr, "kernel_launch: unexpected shapes (n_in %d, in0 %d, out %d, ws %zu); nothing launched\n", n_in, n_in > 0 ? in_sizes[0] : -1, out_size, ws_size); grid = -1; return; }
        int dev = 0, cus = 0, per_cu = 0;
        if (hipGetDevice(&dev) != hipSuccess || hipDeviceGetAttribute(&cus, hipDeviceAttributeMultiprocessorCount, dev) != hipSuccess) { fprintf(stderr, "kernel_launch: device query failed\n"); grid = -1; return; }
        if (hipFuncSetAttribute((const void*)fwd_megakernel, hipFuncAttributeMaxDynamicSharedMemorySize, LDS_BYTES) != hipSuccess) { fprintf(stderr, "kernel_launch: hipFuncSetAttribute failed\n"); grid = -1; return; }
        if (hipOccupancyMaxActiveBlocksPerMultiprocessor(&per_cu, (const void*)fwd_megakernel, NWAVES * 64, LDS_BYTES) != hipSuccess || per_cu < 1) {
            fprintf(stderr, "kernel_launch: occupancy query reports %d workgroups per CU; nothing launched\n", per_cu); (void)hipGetLastError(); grid = -1; return; }
        grid = cus;
    }
    if (grid < 0) return;
    if (hipMemsetAsync((char*)d_ws + WS_CTL, 0, CTL_ZERO_BYTES, stream) != hipSuccess) { fprintf(stderr, "kernel_launch: hipMemsetAsync failed\n"); return; }
    Args a{};
    for (int i = 0; i < 18; ++i) a.in[i] = (const float*)d_in[i];
    a.out = (float*)d_out; a.ws = (unsigned char*)d_ws;
    hipLaunchKernelGGL(fwd_megakernel, dim3(grid), dim3(NWAVES * 64), LDS_BYTES, stream, a);
    const hipError_t le = hipPeekAtLastError();
    if (le != hipSuccess) fprintf(stderr, "kernel_launch: launch failed: %s\n", hipGetErrorName(le));
}
```
